# Optimizing an MI355X kernel written in HIP

```python
import math
import jax, jax.numpy as jnp
from jax import lax
import numpy as np

D_MODEL = 2048
BATCH = 1
SEQ = 16384
DEPTH = 1

CHUNK = 64
MIX_WIDTH = D_MODEL
SSM_WIDTH = MIX_WIDTH // 2
POOL_WIDTH = MIX_WIDTH - SSM_WIDTH
SSM_GROUP = 16
SSM_GROUPS = SSM_WIDTH // SSM_GROUP
SSM_STATE = 64
POOL_WINDOWS = (2, 4, 8, 16)
POOL_GROUPS = len(POOL_WINDOWS)
POOL_GROUP = POOL_WIDTH // POOL_GROUPS
D_FF = ((8 * D_MODEL // 3 + 255) // 256) * 256
EPS = 1e-6
DT_MIN = 1e-3
DT_MAX = 1e-1

kernel_name = "hybrid_s5_multiscale_pool_block"


def rms_norm(x, gain):
    xf = x.astype(jnp.float32)
    y = xf * lax.rsqrt(jnp.mean(xf * xf, axis=-1, keepdims=True) + EPS)
    return y * gain.astype(jnp.float32)


def s5_mixer(u, lam_re, lam_im, log_step, b_re, b_im, c_re, c_im, d_skip, w_glu, b_glu):
    bsz, L, _ = u.shape
    f32 = jnp.float32
    ug = u.astype(f32).reshape(bsz, L, SSM_GROUPS, SSM_GROUP)
    lam = lax.complex(lam_re.astype(f32), lam_im.astype(f32))
    step = jnp.exp(log_step.astype(f32))[:, None]
    lam_bar = jnp.exp(lam * step)
    bmat = lax.complex(b_re.astype(f32), b_im.astype(f32))
    b_bar = ((lam_bar - 1.0) / lam)[..., None] * bmat
    bu = jnp.einsum('blgh,gph->blgp', ug, b_bar)
    a = jnp.broadcast_to(lam_bar, bu.shape)

    def combine(left, right):
        a_l, b_l = left
        a_r, b_r = right
        return a_r * a_l, a_r * b_l + b_r

    _, states = lax.associative_scan(combine, (a, bu), axis=1)
    cmat = lax.complex(c_re.astype(f32), c_im.astype(f32))
    y = jnp.real(jnp.einsum('blgp,ghp->blgh', states, cmat)) + d_skip.astype(f32) * ug
    y = y.reshape(bsz, L, SSM_WIDTH)
    g = jax.nn.gelu(y, approximate=False)
    return g * jax.nn.sigmoid(g @ w_glu.astype(f32) + b_glu.astype(f32))


def pool_mixer(v, w_pool, b_pool, pool_scale):
    bsz, L, _ = v.shape
    f32 = jnp.float32
    vg = v.astype(f32).reshape(bsz, L, POOL_GROUPS, POOL_GROUP)
    cs = jnp.pad(jnp.cumsum(vg, axis=1), ((0, 0), (1, 0), (0, 0), (0, 0)))
    pos1 = jnp.arange(1, L + 1)
    outs = []
    for k, w in enumerate(POOL_WINDOWS):
        c = cs[:, :, k]
        hi = c[:, 1:]
        lo = jnp.pad(c, ((0, 0), (w, 0), (0, 0)))[:, 1:L + 1]
        count = jnp.minimum(pos1, w).astype(f32)[None, :, None]
        outs.append((hi - lo) / count - vg[:, :, k])
    pooled = jnp.stack(outs, axis=2)
    mixed = jnp.einsum('blkc,kcd->blkd', pooled, w_pool.astype(f32)) + b_pool.astype(f32)
    return mixed.reshape(bsz, L, POOL_WIDTH) * pool_scale.astype(f32)


def setup_inputs(seed: int = 0) -> dict:
    key = jax.random.key(seed)
    ks = jax.random.split(key, 24)
    f32 = jnp.float32
    nrm = lambda k, shape, s: jax.random.normal(k, shape, f32) * s
    gain = lambda k, shape: 1.0 + 0.02 * jax.random.normal(k, shape, f32)
    G, P, H = SSM_GROUPS, SSM_STATE, SSM_GROUP
    lam_im0 = jnp.pi * jnp.arange(P, dtype=f32)
    return {
        "x": jax.random.normal(ks[0], (BATCH, SEQ, D_MODEL), f32),
        "norm_mix": gain(ks[1], (DEPTH, D_MODEL)),
        "w_in": nrm(ks[2], (DEPTH, D_MODEL, MIX_WIDTH), D_MODEL ** -0.5),
        "lambda_re": -0.5 + 0.01 * jax.random.normal(ks[3], (DEPTH, G, P), f32),
        "lambda_im": lam_im0 + 0.01 * jax.random.normal(ks[4], (DEPTH, G, P), f32),
        "log_step": jax.random.uniform(ks[5], (DEPTH, G), f32, math.log(DT_MIN), math.log(DT_MAX)),
        "b_re": nrm(ks[6], (DEPTH, G, P, H), (2.0 * H) ** -0.5),
        "b_im": nrm(ks[7], (DEPTH, G, P, H), (2.0 * H) ** -0.5),
        "c_re": nrm(ks[8], (DEPTH, G, H, P), (2.0 * P) ** -0.5),
        "c_im": nrm(ks[9], (DEPTH, G, H, P), (2.0 * P) ** -0.5),
        "d_skip": nrm(ks[10], (DEPTH, G, H), 1.0),
        "w_glu": nrm(ks[11], (DEPTH, SSM_WIDTH, SSM_WIDTH), SSM_WIDTH ** -0.5),
        "b_glu": nrm(ks[12], (DEPTH, SSM_WIDTH), 0.01),
        "w_pool": nrm(ks[13], (DEPTH, POOL_GROUPS, POOL_GROUP, POOL_GROUP), POOL_GROUP ** -0.5),
        "b_pool": nrm(ks[14], (DEPTH, POOL_GROUPS, POOL_GROUP), 0.01),
        "pool_scale": gain(ks[15], (DEPTH, POOL_WIDTH)),
        "w_out": nrm(ks[16], (DEPTH, MIX_WIDTH, D_MODEL), MIX_WIDTH ** -0.5),
        "norm_ffn": gain(ks[17], (DEPTH, D_MODEL)),
        "w_gate": nrm(ks[18], (DEPTH, D_MODEL, D_FF), D_MODEL ** -0.5),
        "w_up": nrm(ks[19], (DEPTH, D_MODEL, D_FF), D_MODEL ** -0.5),
        "w_down": nrm(ks[20], (DEPTH, D_FF, D_MODEL), D_FF ** -0.5),
        "norm_final": gain(ks[21], (D_MODEL,)),
    }


def reference(x, norm_mix, w_in, lambda_re, lambda_im, log_step, b_re, b_im, c_re, c_im,
              d_skip, w_glu, b_glu, w_pool, b_pool, pool_scale, w_out, norm_ffn,
              w_gate, w_up, w_down, norm_final):
    out_dtype = x.dtype
    h_res = x.astype(jnp.float32)
    for l in range(DEPTH):
        h = rms_norm(h_res, norm_mix[l])
        proj = h @ w_in[l].astype(jnp.float32)
        u = proj[..., :SSM_WIDTH]
        v = proj[..., SSM_WIDTH:]
        y_ssm = s5_mixer(u, lambda_re[l], lambda_im[l], log_step[l], b_re[l], b_im[l],
                         c_re[l], c_im[l], d_skip[l], w_glu[l], b_glu[l])
        y_pool = pool_mixer(v, w_pool[l], b_pool[l], pool_scale[l])
        mixed = jnp.concatenate([y_ssm, y_pool], axis=-1)
        h_res = h_res + mixed @ w_out[l].astype(jnp.float32)
        h = rms_norm(h_res, norm_ffn[l])
        ff = jax.nn.silu(h @ w_gate[l].astype(jnp.float32)) * (h @ w_up[l].astype(jnp.float32))
        h_res = h_res + ff @ w_down[l].astype(jnp.float32)
    return rms_norm(h_res, norm_final).astype(out_dtype)
```

```cpp
#include <hip/hip_runtime.h>
#include <cstdio>
#include <cstdint>

#ifndef MK_PROBE_MASK
#define MK_PROBE_MASK 0
#endif
#ifndef MK_PER_PHASE
#define MK_PER_PHASE 0
#endif

namespace pg8 {
#define PG8_LAS __attribute__((address_space(3)))
typedef unsigned short bf16_t;
typedef short bf16x8 __attribute__((ext_vector_type(8)));
typedef float f32x4 __attribute__((ext_vector_type(4)));
typedef float f32x2 __attribute__((ext_vector_type(2)));
typedef unsigned u32x4 __attribute__((ext_vector_type(4)));
constexpr int BM = 256, BK = 64, HALF = 128, HTB = HALF * BK * 2, STAGE_BYTES = 8 * HTB, NXCD = 8, WGM = 8;

__host__ __device__ __forceinline__ int lds_byte(int r, int c) { const int st = (r >> 4) * 2 + (c >> 5), rr = r & 15, cc = c & 31, ob = rr * 64 + cc * 2; return st * 1024 + (ob ^ (((ob >> 9) & 1) << 5)); }
__host__ __device__ __forceinline__ void stage_rc(int b, int& R, int& C) { const int st = b / 1024, sb = b % 1024, swz = sb ^ (((sb >> 9) & 1) << 5); R = (st >> 1) * 16 + swz / 64; C = (st & 1) * 32 + (swz % 64) / 2; }
__host__ __device__ __forceinline__ int perm32(int rho) { const int n = rho >> 4, i = rho & 15; return 8 * (i >> 2) + 4 * n + (i & 3); }

struct Unit { int pm, pn, ntk, kind; long long aoff, boff; };
struct Gemm { const bf16_t* A; const bf16_t* Bt; int lda, ldb, K, hsB; };

struct StaticOrder {
    int nM, nN, nwg, G, c, lda, ldb;
    __device__ void init(int M, int N, int G_, int c_, int lda_, int ldb_) { nM = M / BM; nN = N / BM; nwg = nM * nN; G = G_; c = c_; lda = lda_; ldb = ldb_; }
    __device__ bool next(int i, Unit& u) const {
        const long L = (long)i * G + c; if (L >= nwg) return false;
        int wgid = (int)L; { const int q = nwg / NXCD, r = nwg % NXCD, xcd = wgid % NXCD, off = wgid / NXCD; wgid = (xcd < r ? xcd * (q + 1) : r * (q + 1) + (xcd - r) * q) + off; }
        const int nig = WGM * nN, gid = wgid / nig, fm = gid * WGM, gsz = (nM - fm) < WGM ? (nM - fm) : WGM;
        u.pm = fm + ((wgid % nig) % gsz); u.pn = (wgid % nig) / gsz; u.ntk = 0; u.kind = 0;
        u.aoff = (long long)u.pm * BM * lda; u.boff = (long long)u.pn * BM * ldb; return true;
    }
    __device__ __forceinline__ void a_ready(const Unit&) const {}
    __device__ __forceinline__ void done(const Unit&) const {}
};
struct GroupOrder {
    int n, G, c, lda, per; long long bstride;
    __device__ bool next(int i, Unit& u) const { const int idx = i * G + c; if (idx >= n) return false; u.pm = idx; u.pn = 0; u.ntk = 0; u.kind = 0; u.aoff = (long long)idx * BM * lda; u.boff = (long long)(idx / per) * bstride; return true; }
    __device__ __forceinline__ void a_ready(const Unit&) const {}
    __device__ __forceinline__ void done(const Unit&) const {}
};
struct PoolOrder {
    int n, G, c;
    __device__ bool next(int i, Unit& u) const { const int idx = i * G + c; if (idx >= n) return false; u.pm = idx & 63; u.pn = idx >> 6; u.ntk = 0; u.kind = 0; u.aoff = (long long)u.pm * BM * 1024 + u.pn * 256; u.boff = (long long)u.pn * 256 * 1024; return true; }
    __device__ __forceinline__ void a_ready(const Unit&) const {}
    __device__ __forceinline__ void done(const Unit&) const {}
};

struct GluPoolOrder {
    StaticOrder so; int c; long long a1, b1;
    __device__ bool next(int i, Unit& u) const { if (i == 0) return so.next(0, u); if (i > 1) return false;
        u.pm = c & 63; u.pn = c >> 6; u.ntk = 4; u.kind = 1; u.aoff = a1 + (long long)u.pm * BM * 1024 + u.pn * 256; u.boff = b1 + (long long)u.pn * 256 * 1024; return true; }
    __device__ __forceinline__ void a_ready(const Unit&) const {}
    __device__ __forceinline__ void done(const Unit&) const {}
};
struct PanelOrder {
    int c, lda, ldb;
    __device__ bool next(int i, Unit& u) const { if (i >= 2) return false; const int xcd = c & 7, local = c >> 3; u.pm = xcd * 8 + i * 4 + (local & 3); u.pn = local >> 2; u.ntk = 0; u.kind = 0;
        u.aoff = (long long)u.pm * BM * lda; u.boff = (long long)u.pn * BM * ldb; return true; }
    __device__ __forceinline__ void a_ready(const Unit&) const {}
    __device__ __forceinline__ void done(const Unit&) const {}
};
__device__ __forceinline__ unsigned cvt_pk_bf16(float lo, float hi) { unsigned r; asm volatile("v_cvt_pk_bf16_f32 %0, %1, %2" : "=v"(r) : "v"(lo), "v"(hi)); return r; }
__device__ __forceinline__ f32x2 gelu_pk(f32x2 v) {
    const f32x2 av = __builtin_elementwise_abs(v), d = av * 0.2316418882f + 1.0f;
    f32x2 t; t.x = __builtin_amdgcn_rcpf(d.x); t.y = __builtin_amdgcn_rcpf(d.y);
    f32x2 q = t * 0.5307027145f + (-0.7265760135f); q = q * t + 0.7107068705f; q = q * t + (-0.142248368f); q = q * t + 0.127414796f; q = q * t;
    const f32x2 s = (v * v) * (-0.72134752044f);
    f32x2 e; e.x = __builtin_amdgcn_exp2f(s.x); e.y = __builtin_amdgcn_exp2f(s.y);
    const f32x2 m = v * (q * e), r = v - m;
    f32x2 o; o.x = v.x < 0.f ? m.x : r.x; o.y = v.y < 0.f ? m.y : r.y; return o;
}
__device__ __forceinline__ float sigmoidf_fast(float z) { return __builtin_amdgcn_rcpf(1.0f + __builtin_amdgcn_exp2f(z * -1.4426950408889634f)); }
__device__ __forceinline__ float bf_lo(unsigned w) { return __uint_as_float(w << 16); }
__device__ __forceinline__ float bf_hi(unsigned w) { return __uint_as_float(w & 0xffff0000u); }

struct EpiProj {
    static constexpr bool PERM = true, AFTER_DRAIN = false;
    bf16_t* AG; bf16_t* V; const float* rstd;
    __device__ __forceinline__ void operator()(const f32x4 (&acc)[2][2][4][2], const Unit& u, int wr, int wc, int fr, int fq) const {
        const int row0 = u.pm * BM + wr * 64 + fr, colt = u.pn * BM + wc * 32 + 8 * fq;
        float rsv[2][4];
#pragma unroll
        for (int ai = 0; ai < 2; ++ai)
#pragma unroll
            for (int m = 0; m < 4; ++m) rsv[ai][m] = rstd[row0 + ai * HALF + m * 16];
#pragma unroll
        for (int ai = 0; ai < 2; ++ai)
#pragma unroll
            for (int m = 0; m < 4; ++m) { const int r = row0 + ai * HALF + m * 16; const float rs = rsv[ai][m];
#pragma unroll
                for (int bj = 0; bj < 2; ++bj) { const int c0 = colt + bj * HALF; const f32x4 v0 = acc[ai][bj][m][0] * rs, v1 = acc[ai][bj][m][1] * rs;
                    u32x4 w; w.x = cvt_pk_bf16(v0[0], v0[1]); w.y = cvt_pk_bf16(v0[2], v0[3]); w.z = cvt_pk_bf16(v1[0], v1[1]); w.w = cvt_pk_bf16(v1[2], v1[3]);
                    bf16_t* dst;
                    if (u.pn < 4) { const int g = c0 >> 4, h0 = c0 & 15; dst = AG + ((size_t)(g * 1024 + (r >> 4)) * 384 + (r & 15) * 16 + h0); }
                    else dst = V + (size_t)r * 1024 + (c0 - 1024);
                    *(u32x4*)dst = w; } }
    }
};
struct EpiSloc {
    static constexpr bool PERM = false, AFTER_DRAIN = false;
    float* S;
    __device__ __forceinline__ void operator()(const f32x4 (&acc)[2][2][4][2], const Unit& u, int wr, int wc, int fr, int fq) const {
        const int row0 = u.pm * BM + wr * 64 + fr, col0 = wc * 32 + 4 * fq;
#pragma unroll
        for (int ai = 0; ai < 2; ++ai)
#pragma unroll
            for (int m = 0; m < 4; ++m) { float* rowp = S + (size_t)(row0 + ai * HALF + m * 16) * 128 + col0;
#pragma unroll
                for (int n = 0; n < 2; ++n) *(f32x4*)(rowp + n * 16) = acc[ai][0][m][n]; }
    }
};
struct EpiS5Out {
    static constexpr bool PERM = true, AFTER_DRAIN = false;
    bf16_t* GB;
    __device__ __forceinline__ void operator()(const f32x4 (&acc)[2][2][4][2], const Unit& u, int wr, int wc, int fr, int fq) const {
        const int R0 = u.pm * BM + wr * 64 + fr;
#pragma unroll
        for (int ai = 0; ai < 2; ++ai)
#pragma unroll
            for (int m = 0; m < 4; ++m) { const int R = R0 + ai * HALF + m * 16, g = R >> 10, c = R & 1023;
#pragma unroll
                for (int bj = 0; bj < 2; ++bj) { const int cc = bj * HALF + wc * 32 + 8 * fq, i = cc >> 4, h0 = cc & 15; const f32x4 v0 = acc[ai][bj][m][0], v1 = acc[ai][bj][m][1];
                    const f32x2 a = gelu_pk((f32x2){v0[0], v0[1]}), b = gelu_pk((f32x2){v0[2], v0[3]}), cq = gelu_pk((f32x2){v1[0], v1[1]}), d = gelu_pk((f32x2){v1[2], v1[3]});
                    u32x4 w; w.x = cvt_pk_bf16(a.x, a.y); w.y = cvt_pk_bf16(b.x, b.y); w.z = cvt_pk_bf16(cq.x, cq.y); w.w = cvt_pk_bf16(d.x, d.y);
                    *(u32x4*)(GB + (size_t)(c * 16 + i) * 1024 + g * 16 + h0) = w; } }
    }
};
struct EpiPoolOut {
    static constexpr bool PERM = true, AFTER_DRAIN = false;
    bf16_t* MX; const float* biasp;
    __device__ __forceinline__ void operator()(const f32x4 (&acc)[2][2][4][2], const Unit& u, int wr, int wc, int fr, int fq) const {
        const int row0 = u.pm * BM + wr * 64 + fr, col0 = u.pn * 256 + wc * 32 + 8 * fq;
        f32x4 bv[2][2];
#pragma unroll
        for (int bj = 0; bj < 2; ++bj)
#pragma unroll
            for (int n = 0; n < 2; ++n) bv[bj][n] = *(const f32x4*)(biasp + col0 + bj * HALF + 4 * n);
#pragma unroll
        for (int ai = 0; ai < 2; ++ai)
#pragma unroll
            for (int m = 0; m < 4; ++m) { bf16_t* rowp = MX + (size_t)(row0 + ai * HALF + m * 16) * 2048 + 1024 + col0;
#pragma unroll
                for (int bj = 0; bj < 2; ++bj) { const f32x4 v0 = acc[ai][bj][m][0] + bv[bj][0], v1 = acc[ai][bj][m][1] + bv[bj][1];
                    u32x4 w; w.x = cvt_pk_bf16(v0[0], v0[1]); w.y = cvt_pk_bf16(v0[2], v0[3]); w.z = cvt_pk_bf16(v1[0], v1[1]); w.w = cvt_pk_bf16(v1[2], v1[3]);
                    *(u32x4*)(rowp + bj * HALF) = w; } }
    }
};
struct EpiGlu {
    static constexpr bool PERM = true, AFTER_DRAIN = false;
    bf16_t* MX; const bf16_t* GB; const float* bias;
    __device__ __forceinline__ void operator()(const f32x4 (&acc)[2][2][4][2], const Unit& u, int wr, int wc, int fr, int fq) const {
        const int row0 = u.pm * BM + wr * 64 + fr, col0 = u.pn * BM + wc * 32 + 8 * fq;
        f32x4 bv[2][2];
#pragma unroll
        for (int bj = 0; bj < 2; ++bj)
#pragma unroll
            for (int n = 0; n < 2; ++n) bv[bj][n] = *(const f32x4*)(bias + col0 + bj * HALF + 4 * n);
#pragma unroll
        for (int ai = 0; ai < 2; ++ai) {
            u32x4 gw[4][2];
#pragma unroll
            for (int m = 0; m < 4; ++m)
#pragma unroll
                for (int bj = 0; bj < 2; ++bj) gw[m][bj] = *(const u32x4*)(GB + (size_t)(row0 + ai * HALF + m * 16) * 1024 + col0 + bj * HALF);
#pragma unroll
            for (int m = 0; m < 4; ++m) { const size_t r = (size_t)(row0 + ai * HALF + m * 16);
#pragma unroll
                for (int bj = 0; bj < 2; ++bj) { const u32x4 g4 = gw[m][bj];
                    const f32x4 z0 = acc[ai][bj][m][0] + bv[bj][0], z1 = acc[ai][bj][m][1] + bv[bj][1];
                    const float o0 = bf_lo(g4.x) * sigmoidf_fast(z0[0]), o1 = bf_hi(g4.x) * sigmoidf_fast(z0[1]), o2 = bf_lo(g4.y) * sigmoidf_fast(z0[2]), o3 = bf_hi(g4.y) * sigmoidf_fast(z0[3]);
                    const float o4 = bf_lo(g4.z) * sigmoidf_fast(z1[0]), o5 = bf_hi(g4.z) * sigmoidf_fast(z1[1]), o6 = bf_lo(g4.w) * sigmoidf_fast(z1[2]), o7 = bf_hi(g4.w) * sigmoidf_fast(z1[3]);
                    u32x4 w; w.x = cvt_pk_bf16(o0, o1); w.y = cvt_pk_bf16(o2, o3); w.z = cvt_pk_bf16(o4, o5); w.w = cvt_pk_bf16(o6, o7);
                    *(u32x4*)(MX + r * 2048 + col0 + bj * HALF) = w; } }
            asm volatile("" ::: "memory"); }
    }
};
struct EpiGluPool {
    static constexpr bool PERM = true, AFTER_DRAIN = false;
    EpiGlu a; EpiPoolOut b;
    __device__ __forceinline__ void operator()(const f32x4 (&acc)[2][2][4][2], const Unit& u, int wr, int wc, int fr, int fq) const { if (u.kind == 0) a(acc, u, wr, wc, fr, fq); else b(acc, u, wr, wc, fr, fq); }
};
struct EpiResidA {
    static constexpr bool PERM = true, AFTER_DRAIN = false;
    bf16_t* HB; float* rowss;
    __device__ __forceinline__ void operator()(const f32x4 (&acc)[2][2][4][2], const Unit& u, int wr, int wc, int fr, int fq) const {
        const int row0 = u.pm * BM + wr * 64 + fr, col0 = u.pn * BM + wc * 32 + 8 * fq;
        u32x4 bw[2][4][2];
#pragma unroll
        for (int ai = 0; ai < 2; ++ai)
#pragma unroll
            for (int m = 0; m < 4; ++m)
#pragma unroll
                for (int bj = 0; bj < 2; ++bj) bw[ai][m][bj] = *(const u32x4*)(HB + (size_t)(row0 + ai * HALF + m * 16) * 2048 + col0 + bj * HALF);
#pragma unroll
        for (int ai = 0; ai < 2; ++ai) {
#pragma unroll
            for (int m = 0; m < 4; ++m) { const int r = row0 + ai * HALF + m * 16; const size_t off = (size_t)r * 2048 + col0; float ss = 0.f;
#pragma unroll
                for (int bj = 0; bj < 2; ++bj) { const u32x4 b4 = bw[ai][m][bj]; const f32x4 a0 = acc[ai][bj][m][0], a1 = acc[ai][bj][m][1];
                    const float h0 = bf_lo(b4.x) + a0[0], h1 = bf_hi(b4.x) + a0[1], h2 = bf_lo(b4.y) + a0[2], h3 = bf_hi(b4.y) + a0[3];
                    const float h4 = bf_lo(b4.z) + a1[0], h5 = bf_hi(b4.z) + a1[1], h6 = bf_lo(b4.w) + a1[2], h7 = bf_hi(b4.w) + a1[3];
                    ss += (h0 * h0 + h1 * h1) + (h2 * h2 + h3 * h3) + (h4 * h4 + h5 * h5) + (h6 * h6 + h7 * h7);
                    u32x4 w; w.x = cvt_pk_bf16(h0, h1); w.y = cvt_pk_bf16(h2, h3); w.z = cvt_pk_bf16(h4, h5); w.w = cvt_pk_bf16(h6, h7);
                    *(u32x4*)(HB + off + bj * HALF) = w; }
                ss += __shfl_xor(ss, 16); ss += __shfl_xor(ss, 32);
                if (fq == 0) atomicAdd(rowss + r, ss); }
            asm volatile("" ::: "memory"); }
    }
};
struct EpiFinal {
    static constexpr bool PERM = true, AFTER_DRAIN = false;
    const bf16_t* HB; float* out; float* rowss; unsigned* cnt; unsigned* tmo; const float* gain;
    __device__ __forceinline__ void operator()(f32x4 (&acc)[2][2][4][2], const Unit& u, int wr, int wc, int fr, int fq) const {
        const int row0 = u.pm * BM + wr * 64 + fr, col0 = u.pn * BM + wc * 32 + 8 * fq;
#pragma unroll
        for (int ai = 0; ai < 2; ++ai) {
            u32x4 bw[4][2];
#pragma unroll
            for (int m = 0; m < 4; ++m)
#pragma unroll
                for (int bj = 0; bj < 2; ++bj) bw[m][bj] = *(const u32x4*)(HB + (size_t)(row0 + ai * HALF + m * 16) * 2048 + col0 + bj * HALF);
#pragma unroll
            for (int m = 0; m < 4; ++m) { const int r = row0 + ai * HALF + m * 16; float ss = 0.f;
#pragma unroll
                for (int bj = 0; bj < 2; ++bj) { const u32x4 b4 = bw[m][bj];
                    const f32x4 h0 = acc[ai][bj][m][0] + (f32x4){bf_lo(b4.x), bf_hi(b4.x), bf_lo(b4.y), bf_hi(b4.y)};
                    const f32x4 h1 = acc[ai][bj][m][1] + (f32x4){bf_lo(b4.z), bf_hi(b4.z), bf_lo(b4.w), bf_hi(b4.w)};
                    ss += (h0[0] * h0[0] + h0[1] * h0[1]) + (h0[2] * h0[2] + h0[3] * h0[3]) + (h1[0] * h1[0] + h1[1] * h1[1]) + (h1[2] * h1[2] + h1[3] * h1[3]);
                    acc[ai][bj][m][0] = h0; acc[ai][bj][m][1] = h1; }
                ss += __shfl_xor(ss, 16); ss += __shfl_xor(ss, 32);
                if (fq == 0) atomicAdd(rowss + r, ss); }
            asm volatile("" ::: "memory"); }
        asm volatile("s_waitcnt vmcnt(0)" ::: "memory");
        unsigned* cw = cnt + 64 * u.pm;
        if ((fr | fq) == 0) __hip_atomic_fetch_add(cw, 1u, __ATOMIC_RELAXED, __HIP_MEMORY_SCOPE_AGENT);
        { unsigned sp = 0;
          while ((unsigned)__builtin_amdgcn_readfirstlane(__hip_atomic_load(cw, __ATOMIC_RELAXED, __HIP_MEMORY_SCOPE_AGENT)) < 64u) {
              __builtin_amdgcn_s_sleep(2);
              if (++sp > (1u << 20)) { if ((fr | fq) == 0) __hip_atomic_store(tmo, 1u, __ATOMIC_RELAXED, __HIP_MEMORY_SCOPE_AGENT); break; } } }
        f32x4 gv[2][2]; float rsv[2][4];
#pragma unroll
        for (int bj = 0; bj < 2; ++bj)
#pragma unroll
            for (int n = 0; n < 2; ++n) gv[bj][n] = *(const f32x4*)(gain + col0 + bj * HALF + 4 * n);
#pragma unroll
        for (int ai = 0; ai < 2; ++ai)
#pragma unroll
            for (int m = 0; m < 4; ++m) rsv[ai][m] = __hip_atomic_load(rowss + row0 + ai * HALF + m * 16, __ATOMIC_RELAXED, __HIP_MEMORY_SCOPE_AGENT);
#pragma unroll
        for (int ai = 0; ai < 2; ++ai)
#pragma unroll
            for (int m = 0; m < 4; ++m) { const int r = row0 + ai * HALF + m * 16; const size_t off = (size_t)r * 2048 + col0;
                const float rs = 1.0f / sqrtf(rsv[ai][m] * (1.0f / 2048.0f) + 1e-6f);
#pragma unroll
                for (int bj = 0; bj < 2; ++bj) { *(f32x4*)(out + off + bj * HALF) = acc[ai][bj][m][0] * rs * gv[bj][0]; *(f32x4*)(out + off + bj * HALF + 4) = acc[ai][bj][m][1] * rs * gv[bj][1]; } }
    }
};
struct EpiSwiglu {
    static constexpr bool PERM = true, AFTER_DRAIN = false;
    bf16_t* FF; const float* rowss;
    __device__ __forceinline__ void operator()(const f32x4 (&acc)[2][2][4][2], const Unit& u, int wr, int wc, int fr, int fq) const {
        const int row0 = u.pm * BM + wr * 64 + fr, col0 = u.pn * HALF + wc * 32 + 8 * fq;
        float rsv[2][4];
#pragma unroll
        for (int ai = 0; ai < 2; ++ai)
#pragma unroll
            for (int m = 0; m < 4; ++m) rsv[ai][m] = __hip_atomic_load(rowss + row0 + ai * HALF + m * 16, __ATOMIC_RELAXED, __HIP_MEMORY_SCOPE_AGENT);
#pragma unroll
        for (int ai = 0; ai < 2; ++ai)
#pragma unroll
            for (int m = 0; m < 4; ++m) { const int r = row0 + ai * HALF + m * 16;
                const float rs = 1.0f / sqrtf(rsv[ai][m] * (1.0f / 2048.0f) + 1e-6f);
                const float c1 = rs * -1.4426950408889634f, c2 = rs * rs;
                f32x2 o[4];
#pragma unroll
                for (int n = 0; n < 2; ++n)
#pragma unroll
                    for (int hh = 0; hh < 2; ++hh) { const f32x2 g2 = (f32x2){acc[ai][0][m][n][2 * hh], acc[ai][0][m][n][2 * hh + 1]}, u2 = (f32x2){acc[ai][1][m][n][2 * hh], acc[ai][1][m][n][2 * hh + 1]};
                        const f32x2 z = g2 * c1; f32x2 e; e.x = __builtin_amdgcn_exp2f(z.x); e.y = __builtin_amdgcn_exp2f(z.y);
                        const f32x2 d = e + 1.0f; f32x2 q; q.x = __builtin_amdgcn_rcpf(d.x); q.y = __builtin_amdgcn_rcpf(d.y);
                        o[n * 2 + hh] = ((g2 * u2) * c2) * q; }
                u32x4 w; w.x = cvt_pk_bf16(o[0].x, o[0].y); w.y = cvt_pk_bf16(o[1].x, o[1].y); w.z = cvt_pk_bf16(o[2].x, o[2].y); w.w = cvt_pk_bf16(o[3].x, o[3].y);
                *(u32x4*)(FF + (size_t)r * 5632 + col0) = w; }
    }
};

template <class Epi, class Sched, bool ALIGN_EPI = false, bool SP2 = false>
__device__ __forceinline__ void gemm_phase(PG8_LAS unsigned char* lds, const Gemm g, const Sched& S, const Epi& E) {
    int tid = threadIdx.x; asm volatile("" : "+v"(tid));
    const int wid = __builtin_amdgcn_readfirstlane(tid >> 6), lane = tid & 63, wr = wid >> 2, wc = wid & 3, fr = lane & 15, fq = lane >> 4;
    const int ntg = g.K / BK;
    unsigned voffA[2], voffB[2];
#pragma unroll
    for (int i = 0; i < 2; ++i) { int R, C; stage_rc(tid * 16 + i * 8192, R, C); const int Rb = Epi::PERM ? ((R & ~31) + perm32(R & 31)) : R;
        voffA[i] = (unsigned)(R * g.lda + C) * 2u; voffB[i] = (unsigned)(Rb * g.ldb + C) * 2u; }
    const size_t kstep = (size_t)(BK * 2);
    const size_t hstepA = (size_t)HALF * g.lda * 2, hstepB = (size_t)g.hsB * g.ldb * 2;
    const unsigned ldsw = (unsigned)wid * 1024u;
    const int aoff = lds_byte(wr * 64 + fr, fq * 8), boff = lds_byte(wc * 32 + fr, fq * 8);
#define PG8_SA(b, h) (((b) * 2 + (h)) * HTB)
#define PG8_SB(b, h) ((4 + (b) * 2 + (h)) * HTB)
#define PG8_STAGE(bufoff, gbase, voff) do { _Pragma("unroll") for (int _i = 0; _i < 2; ++_i) \
        __builtin_amdgcn_global_load_lds((const unsigned*)((const char*)(gbase) + (voff)[_i]), (PG8_LAS unsigned*)(lds + (bufoff) + ldsw + _i * 8192), 16, 0, 0); } while (0)
#define PG8_LDA(dst, b, h) do { _Pragma("unroll") for (int m = 0; m < 4; ++m) _Pragma("unroll") for (int k = 0; k < 2; ++k) dst[m][k] = *(const PG8_LAS bf16x8*)(lds + PG8_SA(b, h) + aoff + m * 2048 + k * 1024); } while (0)
#define PG8_LDB(dst, b, h) do { _Pragma("unroll") for (int n = 0; n < 2; ++n) _Pragma("unroll") for (int k = 0; k < 2; ++k) dst[n][k] = *(const PG8_LAS bf16x8*)(lds + PG8_SB(b, h) + boff + n * 2048 + k * 1024); } while (0)
#define PG8_MMA(ai, bj, At, Bt) do { __builtin_amdgcn_s_setprio(1); _Pragma("unroll") for (int m = 0; m < 4; ++m) _Pragma("unroll") for (int n = 0; n < 2; ++n) _Pragma("unroll") for (int k = 0; k < 2; ++k) \
        acc[ai][bj][m][n] = __builtin_amdgcn_mfma_f32_16x16x32_bf16(Bt[n][k], At[m][k], acc[ai][bj][m][n], 0, 0, 0); __builtin_amdgcn_s_setprio(0); } while (0)
#define PG8_WAIT_V(n) asm volatile("s_waitcnt vmcnt(" #n ")" ::: "memory")
#define PG8_WAIT_L(n) asm volatile("s_waitcnt lgkmcnt(" #n ")" ::: "memory")
#define PG8_BAR __builtin_amdgcn_s_barrier()
#define PG8_SCHED __builtin_amdgcn_sched_barrier(0)
    Unit cur, nxt; int ui = 0;
    if (!S.next(0, cur)) return;
    f32x4 acc[2][2][4][2];
#pragma unroll
    for (int a = 0; a < 2; ++a)
#pragma unroll
        for (int b = 0; b < 2; ++b)
#pragma unroll
            for (int m = 0; m < 4; ++m)
#pragma unroll
                for (int n = 0; n < 2; ++n) acc[a][b][m][n] = (f32x4){0.f, 0.f, 0.f, 0.f};
    bf16x8 At[4][2], B0[2][2], B1[2][2];
    const char* cA = (const char*)g.A + cur.aoff * 2; const char* cB = (const char*)g.Bt + cur.boff * 2;
    S.a_ready(cur);
    if constexpr (SP2) {
        PG8_STAGE(PG8_SB(0, 0), cB, voffB); PG8_STAGE(PG8_SB(0, 1), cB + hstepB, voffB); PG8_STAGE(PG8_SA(0, 0), cA, voffA); PG8_STAGE(PG8_SA(0, 1), cA + hstepA, voffA);
        if (wr == 1) PG8_BAR;
        PG8_WAIT_V(2); PG8_BAR;
        PG8_STAGE(PG8_SB(1, 0), cB + kstep, voffB); PG8_STAGE(PG8_SA(1, 0), cA + kstep, voffA); PG8_STAGE(PG8_SB(1, 1), cB + hstepB + kstep, voffB);
        PG8_WAIT_V(6); PG8_BAR;
    } else {
        PG8_STAGE(PG8_SB(0, 0), cB, voffB); PG8_STAGE(PG8_SA(0, 0), cA, voffA); PG8_STAGE(PG8_SB(0, 1), cB + hstepB, voffB); PG8_STAGE(PG8_SA(0, 1), cA + hstepA, voffA);
        if (wr == 1) PG8_BAR;
        PG8_WAIT_V(4); PG8_BAR;
        PG8_STAGE(PG8_SB(1, 0), cB + kstep, voffB); PG8_STAGE(PG8_SA(1, 0), cA + kstep, voffA); PG8_STAGE(PG8_SB(1, 1), cB + hstepB + kstep, voffB);
        PG8_WAIT_V(6); PG8_BAR;
    }
    for (;;) {
        const bool has_next = S.next(ui + 1, nxt);
        const char* nA = has_next ? (const char*)g.A + nxt.aoff * 2 : cA; const char* nB = has_next ? (const char*)g.Bt + nxt.boff * 2 : cB;
        const int nt = cur.ntk ? cur.ntk : ntg;
        for (int t = 0; t < nt; t += 2) {
            const bool last = (t == nt - 2);
            const char* a1 = cA + (size_t)(t + 1) * kstep;
            const char* a2 = last ? nA : cA + (size_t)(t + 2) * kstep; const char* b2 = last ? nB : cB + (size_t)(t + 2) * kstep;
            const char* a3 = a2 + kstep; const char* b3 = b2 + kstep;
            if (last && has_next) S.a_ready(nxt);
            if constexpr (SP2) {
            PG8_LDB(B0, 0, 0); PG8_LDB(B1, 0, 1); PG8_SCHED; PG8_LDA(At, 0, 0); PG8_STAGE(PG8_SA(1, 1), a1 + hstepA, voffA);
            PG8_WAIT_V(8); PG8_WAIT_L(0); PG8_BAR; PG8_MMA(0, 0, At, B0); PG8_MMA(0, 1, At, B1); PG8_BAR; PG8_SCHED;
            PG8_LDA(At, 0, 1); PG8_STAGE(PG8_SB(0, 0), b2, voffB); PG8_STAGE(PG8_SB(0, 1), b2 + hstepB, voffB); PG8_STAGE(PG8_SA(0, 0), a2, voffA);
            PG8_WAIT_V(8); PG8_WAIT_L(0); PG8_BAR; PG8_MMA(1, 0, At, B0); PG8_MMA(1, 1, At, B1); PG8_BAR; PG8_SCHED;
            PG8_LDB(B0, 1, 0); PG8_LDB(B1, 1, 1); PG8_SCHED; PG8_LDA(At, 1, 0); PG8_STAGE(PG8_SA(0, 1), a2 + hstepA, voffA);
            PG8_WAIT_V(8); PG8_WAIT_L(0); PG8_BAR; PG8_MMA(0, 0, At, B0); PG8_MMA(0, 1, At, B1); PG8_BAR; PG8_SCHED;
            PG8_LDA(At, 1, 1); PG8_STAGE(PG8_SB(1, 0), b3, voffB); PG8_STAGE(PG8_SB(1, 1), b3 + hstepB, voffB); PG8_STAGE(PG8_SA(1, 0), a3, voffA);
            PG8_WAIT_V(8); PG8_WAIT_L(0); PG8_BAR; PG8_MMA(1, 0, At, B0); PG8_MMA(1, 1, At, B1); PG8_BAR; PG8_SCHED;
            } else {
            PG8_LDB(B0, 0, 0); PG8_SCHED; PG8_LDA(At, 0, 0); PG8_STAGE(PG8_SA(1, 1), a1 + hstepA, voffA);
            PG8_WAIT_L(8); PG8_BAR; PG8_WAIT_L(0); PG8_MMA(0, 0, At, B0); PG8_BAR; PG8_SCHED;
            PG8_LDB(B1, 0, 1); PG8_STAGE(PG8_SB(0, 0), b2, voffB);
            PG8_BAR; PG8_WAIT_L(0); PG8_MMA(0, 1, At, B1); PG8_BAR;
            PG8_LDA(At, 0, 1); PG8_STAGE(PG8_SA(0, 0), a2, voffA);
            PG8_BAR; PG8_WAIT_L(0); PG8_MMA(1, 0, At, B0); PG8_BAR; PG8_SCHED;
            PG8_STAGE(PG8_SB(0, 1), b2 + hstepB, voffB);
            PG8_WAIT_V(6); PG8_BAR; PG8_MMA(1, 1, At, B1); PG8_BAR;
            PG8_LDB(B0, 1, 0); PG8_SCHED; PG8_LDA(At, 1, 0); PG8_STAGE(PG8_SA(0, 1), a2 + hstepA, voffA);
            PG8_WAIT_L(8); PG8_BAR; PG8_WAIT_L(0); PG8_MMA(0, 0, At, B0); PG8_BAR; PG8_SCHED;
            PG8_LDB(B1, 1, 1); PG8_STAGE(PG8_SB(1, 0), b3, voffB);
            PG8_BAR; PG8_WAIT_L(0); PG8_MMA(0, 1, At, B1); PG8_BAR;
            PG8_LDA(At, 1, 1); PG8_STAGE(PG8_SA(1, 0), a3, voffA);
            PG8_BAR; PG8_WAIT_L(0); PG8_MMA(1, 0, At, B0); PG8_BAR; PG8_SCHED;
            PG8_STAGE(PG8_SB(1, 1), b3 + hstepB, voffB);
            PG8_WAIT_V(6); PG8_BAR; PG8_MMA(1, 1, At, B1); PG8_BAR;
            }
        }
        if constexpr (ALIGN_EPI) { if (wr == 0) PG8_BAR; }
        if constexpr (!Epi::AFTER_DRAIN) { int fr2 = fr, fq2 = fq; asm volatile("" : "+v"(fr2), "+v"(fq2));
            E(acc, cur, wr, wc, fr2, fq2); S.done(cur); }
        if (!has_next) break;
#pragma unroll
        for (int a = 0; a < 2; ++a)
#pragma unroll
            for (int b = 0; b < 2; ++b)
#pragma unroll
                for (int m = 0; m < 4; ++m)
#pragma unroll
                    for (int n = 0; n < 2; ++n) acc[a][b][m][n] = (f32x4){0.f, 0.f, 0.f, 0.f};
        cur = nxt; cA = nA; cB = nB; ++ui;
        if constexpr (ALIGN_EPI) { if (wr == 1) PG8_BAR; }
    }
    PG8_WAIT_V(0);
    if constexpr (!ALIGN_EPI) { if (wr == 0) PG8_BAR; }
    PG8_BAR;
#undef PG8_SA
#undef PG8_SB
#undef PG8_STAGE
#undef PG8_LDA
#undef PG8_LDB
#undef PG8_MMA
#undef PG8_WAIT_V
#undef PG8_WAIT_L
#undef PG8_BAR
#undef PG8_SCHED
}
}

#ifndef PG8_SP2
#define PG8_SP2 true
#endif
#ifndef PG8_ALIGN
#define PG8_ALIGN true
#endif

constexpr int NWAVES = 8;
constexpr int SEQ = 16384, DM = 2048, SSMW = 1024, NGRP = 64, NST = 64, NHC = 16, DFF = 5632, TCH = 16, NCHK = SEQ / TCH, AGK = 384;
constexpr size_t MiB = 1u << 20;
constexpr size_t WS_CTL = 0, CTL_ZERO_BYTES = 1 * MiB;
constexpr size_t WS_WIN = 1 * MiB, WS_WGLU = 9 * MiB, WS_WPOOL = 406 * MiB, WS_BIASP = 11 * MiB + 512 * 1024, WS_LT = WS_BIASP + 64 * 1024, WS_RSTD1 = WS_BIASP + 128 * 1024, WS_XE = WS_BIASP + 256 * 1024;
constexpr size_t WS_WOUT = 12 * MiB, WS_WGU = 20 * MiB, WS_WDOWN = 64 * MiB, WS_BTA = 86 * MiB, WS_BTB = 90 * MiB, WS_XB = 102 * MiB;
constexpr size_t WS_AG = 166 * MiB, WS_V = 214 * MiB, WS_SLOC = 246 * MiB, WS_GBUF = 278 * MiB, WS_POOLED = 310 * MiB, WS_FF = 166 * MiB, WS_MIXED = 342 * MiB, WS_END = 408 * MiB;
static_assert(WS_FF + (size_t)SEQ * DFF * 2 <= WS_MIXED && WS_AG + (size_t)NGRP * NCHK * AGK * 2 <= WS_V && WS_BTB + (size_t)NGRP * 256 * AGK * 2 <= WS_XB && WS_WDOWN + (size_t)DM * DFF * 2 <= WS_BTA, "ws map");
constexpr int CW_TMO = 0, CW_BAR = 4096, CW_PANEL = 196608, CW_XF = 212992;
constexpr size_t CTL_ROWSS2 = 256 * 1024, CTL_ROWSS3 = 512 * 1024;
constexpr int RING_OFF = 0, RING_BYTES = 131072, LDSCTL_OFF = RING_BYTES, MISC_OFF = LDSCTL_OFF + 320, LDS_BYTES = 147456;
constexpr int N_PHASES = 9;

#define LAS __attribute__((address_space(3)))
typedef unsigned short bf16;
typedef unsigned v4u __attribute__((ext_vector_type(4)));
typedef unsigned v2u __attribute__((ext_vector_type(2)));
typedef float f32x4 __attribute__((ext_vector_type(4)));
#define LDS_WAIT() asm volatile("s_waitcnt lgkmcnt(0)" ::: "memory")
#define VM_WAIT() asm volatile("s_waitcnt vmcnt(0)" ::: "memory")
__device__ __forceinline__ unsigned f2bf(float f) { unsigned u = __builtin_bit_cast(unsigned, f); return (u + 0x7fffu + ((u >> 16) & 1u)) >> 16; }
__device__ __forceinline__ unsigned pk2(float lo, float hi) { return f2bf(lo) | (f2bf(hi) << 16); }

#define XB_TMO      128
#define XB_XCNT(j)  (256  + 64 * (j))
#define XB_XSUB(j)  (1280 + 64 * (j))
#define XB_XGEN(j)  (2304 + 64 * (j))
#define XB_TOP      3328
#define XB_TOPGEN   3392
#define XCD_BAR_WORDS 3456
#define XB_SPIN_CAP (1u << 18)
__device__ __forceinline__ unsigned xb_ld(unsigned* p)              { return __hip_atomic_load(p, __ATOMIC_RELAXED, __HIP_MEMORY_SCOPE_AGENT); }
__device__ __forceinline__ unsigned xb_add(unsigned* p, unsigned v) { return __hip_atomic_fetch_add(p, v, __ATOMIC_RELAXED, __HIP_MEMORY_SCOPE_AGENT); }
__device__ __forceinline__ unsigned xb_xcc_id() { return (unsigned)__builtin_amdgcn_s_getreg((3 << 11) | 20) & 0xFu; }
#define XB_SPIN(cond, bar) do { unsigned _sp = 0; while (cond) { __builtin_amdgcn_s_sleep(1); \
    if ((++_sp & 255u) == 0u) { if (xb_ld(&(bar)[XB_TMO])) break; if (_sp > XB_SPIN_CAP) { atomicAdd(&(bar)[XB_TMO], 1u); break; } } } } while (0)
struct XcdBarrier { unsigned* bar; unsigned x; volatile LAS unsigned* st; };
__device__ __forceinline__ XcdBarrier xcd_barrier_post(unsigned* bar, volatile LAS unsigned* st) {
    XcdBarrier b; b.bar = bar; b.x = xb_xcc_id(); b.st = st;
    if (threadIdx.x == 0) (void)xb_add(&bar[XB_XCNT(b.x)], 1u);
    return b;
}
__device__ __forceinline__ void xcd_barrier_complete(unsigned* bar, unsigned x, unsigned& nloc, unsigned& nx) {
    const unsigned G = gridDim.x * gridDim.y * gridDim.z;
    unsigned sum, cnt, mine, sp = 0u;
    for (;;) {
        sum = 0u; cnt = 0u; mine = 0u;
#pragma unroll
        for (unsigned j = 0; j < 16; ++j) { const unsigned c = xb_ld(&bar[XB_XCNT(j)]); sum += c; cnt += (c > 0u) ? 1u : 0u; mine = (j == x) ? c : mine; }
        if (sum == G) break;
        __builtin_amdgcn_s_sleep(1);
        if ((++sp & 255u) == 0u) { if (xb_ld(&bar[XB_TMO])) break; if (sp > XB_SPIN_CAP) { atomicAdd(&bar[XB_TMO], 1u); break; } }
    }
    nloc = mine > 0u ? mine : 1u; nx = cnt > 0u ? cnt : 1u;
}
__device__ __forceinline__ void xcd_barrier_protocol(const XcdBarrier& b) {
    unsigned* bar = b.bar;
    __builtin_amdgcn_s_waitcnt(0);
    unsigned nloc = b.st[0], nx = b.st[1];
    if (nloc == 0u) { xcd_barrier_complete(bar, b.x, nloc, nx); b.st[0] = nloc; b.st[1] = nx; }
    const unsigned old = xb_add(&bar[XB_XSUB(b.x)], 1u);
    const unsigned gen = old / nloc;
    if (old + 1u == (gen + 1u) * nloc) {
        __builtin_amdgcn_fence(__ATOMIC_RELEASE, "agent");
        asm volatile("s_waitcnt vmcnt(0)" ::: "memory");
        const unsigned og = xb_add(&bar[XB_TOP], 1u);
        const unsigned tg = og / nx;
        if (og + 1u == (tg + 1u) * nx) xb_add(&bar[XB_TOPGEN], 1u);
        else XB_SPIN(xb_ld(&bar[XB_TOPGEN]) == tg, bar);
        __builtin_amdgcn_fence(__ATOMIC_ACQUIRE, "agent");
        xb_add(&bar[XB_XGEN(b.x)], 1u);
        asm volatile("s_waitcnt vmcnt(0)" ::: "memory");
    } else {
        XB_SPIN(xb_ld(&bar[XB_XGEN(b.x)]) == gen, bar);
        __builtin_amdgcn_fence(__ATOMIC_ACQUIRE, "agent");
        asm volatile("s_waitcnt vmcnt(0)" ::: "memory");
    }
}
__device__ __forceinline__ void xcd_barrier(const XcdBarrier& b) {
    asm volatile("s_waitcnt vmcnt(0)" ::: "memory");
    __syncthreads();
    if (threadIdx.x == 0) xcd_barrier_protocol(b);
    __syncthreads();
}

__device__ __forceinline__ float wave_sum(float v) {
#pragma unroll
    for (int o = 1; o < 64; o <<= 1) v += __shfl_xor(v, o);
    return v;
}

struct TItem { const float* W; bf16* WT; const float* ks; const float* ns; int N, ldt, orow, k0, n0; float kson, nson; };
__device__ __forceinline__ void titem_decode(int it, TItem& d, const float* const* in, bf16* WIN, bf16* WGLU, bf16* WPOOL, bf16* WOUT, bf16* WGU, bf16* WDOWN) {
    constexpr int I_IN = 32 * 64, I_GLU = 16 * 32, I_POOL = 4 * 32, I_OUT = 32 * 64, I_G = 32 * 176;
    int r = it; d.ks = in[1]; d.ns = in[1]; d.kson = 0.f; d.nson = 0.f;
    if (r < I_IN) { const int kb = r / 64, nb = r % 64; d.W = in[2]; d.N = DM; d.WT = WIN; d.ldt = DM; d.orow = 32 * nb; d.k0 = 64 * kb; d.n0 = 32 * nb; d.ks = in[1]; d.kson = 1.f; return; } r -= I_IN;
    if (r < I_GLU) { const int kb = r / 32, nb = r % 32; d.W = in[11]; d.N = SSMW; d.WT = WGLU; d.ldt = SSMW; d.orow = 32 * nb; d.k0 = 64 * kb; d.n0 = 32 * nb; return; } r -= I_GLU;
    if (r < I_POOL) { const int kg = r / 32, q = r % 32, kb = q / 8, nb = q % 8; d.W = in[13] + (size_t)kg * 65536; d.N = 256; d.WT = WPOOL + (size_t)kg * 256 * 1024; d.ldt = 1024; d.orow = 32 * nb; d.k0 = 64 * kb; d.n0 = 32 * nb;
        d.ns = in[15] + kg * 256; d.nson = 1.f; return; } r -= I_POOL;
    if (r < I_OUT) { const int kb = r / 64, nb = r % 64; d.W = in[16]; d.N = DM; d.WT = WOUT; d.ldt = DM; d.orow = 32 * nb; d.k0 = 64 * kb; d.n0 = 32 * nb; return; } r -= I_OUT;
    if (r < I_G) { const int kb = r / 176, nb = r % 176, n0 = 32 * nb; d.W = in[18]; d.N = DFF; d.WT = WGU; d.ldt = DM; d.orow = (n0 >> 7) * 256 + (n0 & 127); d.k0 = 64 * kb; d.n0 = n0; d.ks = in[17]; d.kson = 1.f; return; } r -= I_G;
    if (r < I_G) { const int kb = r / 176, nb = r % 176, n0 = 32 * nb; d.W = in[19]; d.N = DFF; d.WT = WGU; d.ldt = DM; d.orow = (n0 >> 7) * 256 + 128 + (n0 & 127); d.k0 = 64 * kb; d.n0 = n0; d.ks = in[17]; d.kson = 1.f; return; } r -= I_G;
    { const int kb = r / 64, nb = r % 64; d.W = in[20]; d.N = DM; d.WT = WDOWN; d.ldt = DFF; d.orow = 32 * nb; d.k0 = 64 * kb; d.n0 = 32 * nb; }
}
__device__ __forceinline__ void titem_load(const TItem& d, float (&v)[32], int lane) {
#pragma unroll
    for (int i = 0; i < 32; ++i) { const int kk = 2 * i + (lane >> 5); v[i] = __builtin_nontemporal_load(d.W + ((size_t)(d.k0 + kk) * d.N + d.n0 + (lane & 31))); }
}
__device__ __forceinline__ void titem_store(const TItem& d, const float (&v)[32], LAS float* scr, int lane) {
#pragma unroll
    for (int i = 0; i < 32; ++i) { const int kk = 2 * i + (lane >> 5); const float sc = d.ks[(d.k0 + kk) & 2047] * d.kson + (1.0f - d.kson); scr[kk * 33 + (lane & 31)] = v[i] * sc; }
    LDS_WAIT(); asm volatile("" ::: "memory");
    const int c = lane & 7;
#pragma unroll
    for (int j = 0; j < 4; ++j) { const int n = (lane >> 3) + 8 * j; const LAS float* s = scr + (8 * c) * 33 + n; const float sc = d.ns[(d.n0 + n) & 255] * d.nson + (1.0f - d.nson);
        v4u o; o.x = pk2(s[0 * 33] * sc, s[1 * 33] * sc); o.y = pk2(s[2 * 33] * sc, s[3 * 33] * sc); o.z = pk2(s[4 * 33] * sc, s[5 * 33] * sc); o.w = pk2(s[6 * 33] * sc, s[7 * 33] * sc);
        *(v4u*)(d.WT + (size_t)(d.orow + n) * d.ldt + d.k0 + 8 * c) = o; }
    LDS_WAIT(); asm volatile("" ::: "memory");
}
__device__ __forceinline__ void titem_run(int it, const float* const* in, bf16* WIN, bf16* WGLU, bf16* WPOOL, bf16* WOUT, bf16* WGU, bf16* WDOWN, LAS float* scr, int lane) {
    TItem d; float v[32]; titem_decode(it, d, in, WIN, WGLU, WPOOL, WOUT, WGU, WDOWN); titem_load(d, v, lane); titem_store(d, v, scr, lane);
}
__device__ __forceinline__ void x_rows2_to_bf16(const float* x, bf16* XBp, float* rstd, int m0, int m1, int lane) {
    const f32x4* xa = (const f32x4*)(x + (size_t)m0 * DM) + lane; const f32x4* xc = (const f32x4*)(x + (size_t)m1 * DM) + lane; f32x4 va[8], vc[8];
#pragma unroll
    for (int j = 0; j < 8; ++j) va[j] = __builtin_nontemporal_load(xa + 64 * j);
#pragma unroll
    for (int j = 0; j < 8; ++j) vc[j] = __builtin_nontemporal_load(xc + 64 * j);
    float sa = 0.f, sc = 0.f;
#pragma unroll
    for (int j = 0; j < 8; ++j) { sa += (va[j].x * va[j].x + va[j].y * va[j].y) + (va[j].z * va[j].z + va[j].w * va[j].w); sc += (vc[j].x * vc[j].x + vc[j].y * vc[j].y) + (vc[j].z * vc[j].z + vc[j].w * vc[j].w); }
    sa = wave_sum(sa); sc = wave_sum(sc);
    if (lane == 0) { rstd[m0] = 1.0f / sqrtf(sa * (1.0f / DM) + 1e-6f); rstd[m1] = 1.0f / sqrtf(sc * (1.0f / DM) + 1e-6f); }
    v2u* oa = (v2u*)(XBp + (size_t)m0 * DM) + lane; v2u* oc = (v2u*)(XBp + (size_t)m1 * DM) + lane;
#pragma unroll
    for (int j = 0; j < 8; ++j) { v2u w; w.x = pk2(va[j].x, va[j].y); w.y = pk2(va[j].z, va[j].w); oa[64 * j] = w; }
#pragma unroll
    for (int j = 0; j < 8; ++j) { v2u w; w.x = pk2(vc[j].x, vc[j].y); w.y = pk2(vc[j].z, vc[j].w); oc[64 * j] = w; }
}
__device__ __forceinline__ void s5_tables_group(int g, LAS unsigned char* lds, int tid, const float* lre, const float* lim, const float* lstep, const float* bre, const float* bim,
                                                const float* cre, const float* cim, const float* dsk, bf16* BtA, bf16* BtB, float* LT) {
    LAS float* Lp = (LAS float*)lds;
    LAS float* Bb = Lp + 17 * 64 * 2;
    LAS float* Cc = Bb + 2048;
    LAS float* Kt = Cc + 2048;
    if (tid < 64) { const int p = tid;
        const double step = exp((double)lstep[g]), lr = lre[g * 64 + p], li = lim[g * 64 + p];
        const double er = exp(lr * step), Lr = er * cos(li * step), Li = er * sin(li * step);
        double pr = 1.0, pi = 0.0;
        for (int tau = 0; tau <= 16; ++tau) { Lp[(tau * 64 + p) * 2] = (float)pr; Lp[(tau * 64 + p) * 2 + 1] = (float)pi; const double nr = pr * Lr - pi * Li, ni = pr * Li + pi * Lr; pr = nr; pi = ni; }
        LT[(g * 64 + p) * 2] = Lp[(16 * 64 + p) * 2]; LT[(g * 64 + p) * 2 + 1] = Lp[(16 * 64 + p) * 2 + 1];
        const double nr = Lr - 1.0, ni = Li, den = lr * lr + li * li, qr = (nr * lr + ni * li) / den, qi = (ni * lr - nr * li) / den;
        for (int h = 0; h < 16; ++h) { const double br = bre[(g * 64 + p) * 16 + h], bi = bim[(g * 64 + p) * 16 + h];
            Bb[(p * 16 + h) * 2] = (float)(qr * br - qi * bi); Bb[(p * 16 + h) * 2 + 1] = (float)(qr * bi + qi * br); } }
    for (int idx = tid; idx < 1024; idx += 512) { Cc[idx * 2] = cre[g * 1024 + idx]; Cc[idx * 2 + 1] = cim[g * 1024 + idx]; }
    __syncthreads();
    for (int e = tid; e < 4096; e += 512) { const int tau = e >> 8, hp = (e >> 4) & 15, h = e & 15; float sum = 0.f;
        for (int p = 0; p < 64; ++p) { const float cr = Cc[(hp * 64 + p) * 2], ci = Cc[(hp * 64 + p) * 2 + 1], lr = Lp[(tau * 64 + p) * 2], li = Lp[(tau * 64 + p) * 2 + 1];
            const float er = cr * lr - ci * li, ei = cr * li + ci * lr; sum += er * Bb[(p * 16 + h) * 2] - ei * Bb[(p * 16 + h) * 2 + 1]; }
        if (tau == 0 && hp == h) sum += dsk[g * 16 + h];
        Kt[e] = sum; }
    __syncthreads();
    for (int e = tid; e < 256 * 192; e += 512) { const int row = e / 192, col = 2 * (e % 192), i = row >> 4, hp = row & 15; float v0, v1;
        if (col < 256) { const int j = col >> 4, h = col & 15; v0 = j <= i ? Kt[((i - j) * 16 + hp) * 16 + h] : 0.f; v1 = j <= i ? Kt[((i - j) * 16 + hp) * 16 + h + 1] : 0.f; }
        else { const int im = col >= 320, p = (col - 256) & 63; float e0, e1;
            { const float cr = Cc[(hp * 64 + p) * 2], ci = Cc[(hp * 64 + p) * 2 + 1], lr = Lp[((i + 1) * 64 + p) * 2], li = Lp[((i + 1) * 64 + p) * 2 + 1]; e0 = im ? -(cr * li + ci * lr) : (cr * lr - ci * li); }
            { const float cr = Cc[(hp * 64 + p + 1) * 2], ci = Cc[(hp * 64 + p + 1) * 2 + 1], lr = Lp[((i + 1) * 64 + p + 1) * 2], li = Lp[((i + 1) * 64 + p + 1) * 2 + 1]; e1 = im ? -(cr * li + ci * lr) : (cr * lr - ci * li); }
            v0 = e0; v1 = e1; }
        *(unsigned*)(BtB + ((size_t)(g * 256 + row)) * AGK + col) = pk2(v0, v1); }
    for (int e = tid; e < 128 * 128; e += 512) { const int q = e >> 7, col = 2 * (e & 127), p = q & 63, im = q >> 6, j = col >> 4, h = col & 15;
        const float lr = Lp[((15 - j) * 64 + p) * 2], li = Lp[((15 - j) * 64 + p) * 2 + 1];
        const float b0r = Bb[(p * 16 + h) * 2], b0i = Bb[(p * 16 + h) * 2 + 1], b1r = Bb[(p * 16 + h + 1) * 2], b1i = Bb[(p * 16 + h + 1) * 2 + 1];
        const float v0 = im ? (lr * b0i + li * b0r) : (lr * b0r - li * b0i), v1 = im ? (lr * b1i + li * b1r) : (lr * b1r - li * b1i);
        *(unsigned*)(BtA + ((size_t)(g * 128 + q)) * 256 + col) = pk2(v0, v1); }
    __syncthreads();
}
__device__ __forceinline__ void s5_scan_item(int w, LAS unsigned char* lds, int tid, const float* SLOC, const float* LT, bf16* AG) {
    const int g = w >> 2, p = (w & 3) * 16 + (tid & 15), seg = tid >> 4, pl = tid & 15;
    const float Lr = LT[(g * 64 + p) * 2], Li = LT[(g * 64 + p) * 2 + 1];
    const float* base = SLOC + ((size_t)(g * NCHK + seg * 32)) * 128 + p;
    float ar[32], ai[32];
#pragma unroll
    for (int k = 0; k < 32; ++k) { ar[k] = base[(size_t)k * 128]; ai[k] = base[(size_t)k * 128 + 64]; }
    float sr = 0.f, si = 0.f;
#pragma unroll
    for (int k = 0; k < 32; ++k) { const float tr = ar[k], ti = ai[k]; ar[k] = sr; ai[k] = si; const float nr = Lr * sr - Li * si + tr, ni = Lr * si + Li * sr + ti; sr = nr; si = ni; }
    LAS float* End = (LAS float*)lds;
    End[(seg * 16 + pl) * 2] = sr; End[(seg * 16 + pl) * 2 + 1] = si;
    __syncthreads();
    float Mr = Lr, Mi = Li;
#pragma unroll
    for (int q = 0; q < 5; ++q) { const float nr = Mr * Mr - Mi * Mi, ni = 2.f * Mr * Mi; Mr = nr; Mi = ni; }
    float cr = 0.f, ci = 0.f;
    for (int s2 = 0; s2 < seg; ++s2) { const float er = End[(s2 * 16 + pl) * 2], ei = End[(s2 * 16 + pl) * 2 + 1]; const float nr = Mr * cr - Mi * ci + er, ni = Mr * ci + Mi * cr + ei; cr = nr; ci = ni; }
    bf16* dst = AG + ((size_t)(g * NCHK + seg * 32)) * AGK + 256 + p;
#pragma unroll
    for (int k = 0; k < 32; ++k) { dst[(size_t)k * AGK] = (bf16)f2bf(ar[k] + cr); dst[(size_t)k * AGK + 64] = (bf16)f2bf(ai[k] + ci); const float nr = Lr * cr - Li * ci, ni = Lr * ci + Li * cr; cr = nr; ci = ni; }
    __syncthreads();
}
template <int KG> __device__ __forceinline__ void pool_half_t(int tb, int oct, const bf16* V, bf16* PO) {
    constexpr int W = 2 << KG, NR = 7 + W;
    const bf16* vp = V + oct * 8; bf16* op = PO + oct * 8;
    v4u q[NR];
#pragma unroll
    for (int j = 0; j < NR; ++j) { const int sr = tb - (W - 1) + j; q[j] = (v4u){0u, 0u, 0u, 0u}; if (sr >= 0) q[j] = *(const v4u*)(vp + (size_t)sr * 1024); }
    float sum[8];
#pragma unroll
    for (int j = 0; j < 8; ++j) sum[j] = 0.f;
#pragma unroll
    for (int j = 0; j < W - 1; ++j) { const v4u r = q[j];
        sum[0] += pg8::bf_lo(r.x); sum[1] += pg8::bf_hi(r.x); sum[2] += pg8::bf_lo(r.y); sum[3] += pg8::bf_hi(r.y); sum[4] += pg8::bf_lo(r.z); sum[5] += pg8::bf_hi(r.z); sum[6] += pg8::bf_lo(r.w); sum[7] += pg8::bf_hi(r.w); }
#pragma unroll
    for (int i = 0; i < 8; ++i) { const int t = tb + i; const v4u c = q[W - 1 + i];
        const float cur[8] = {pg8::bf_lo(c.x), pg8::bf_hi(c.x), pg8::bf_lo(c.y), pg8::bf_hi(c.y), pg8::bf_lo(c.z), pg8::bf_hi(c.z), pg8::bf_lo(c.w), pg8::bf_hi(c.w)};
        const float inv = 1.0f / (float)(t + 1 < W ? t + 1 : W); float o[8];
#pragma unroll
        for (int j = 0; j < 8; ++j) { sum[j] += cur[j]; o[j] = sum[j] * inv - cur[j]; }
        v4u ow; ow.x = pk2(o[0], o[1]); ow.y = pk2(o[2], o[3]); ow.z = pk2(o[4], o[5]); ow.w = pk2(o[6], o[7]);
        *(v4u*)(op + (size_t)t * 1024) = ow;
        const v4u r = q[i];
        sum[0] -= pg8::bf_lo(r.x); sum[1] -= pg8::bf_hi(r.x); sum[2] -= pg8::bf_lo(r.y); sum[3] -= pg8::bf_hi(r.y); sum[4] -= pg8::bf_lo(r.z); sum[5] -= pg8::bf_hi(r.z); sum[6] -= pg8::bf_lo(r.w); sum[7] -= pg8::bf_hi(r.w); }
}
__device__ __forceinline__ void pool_half(int kg, int tb, int oct, const bf16* V, bf16* PO) {
    if (kg == 0) pool_half_t<0>(tb, oct, V, PO); else if (kg == 1) pool_half_t<1>(tb, oct, V, PO); else if (kg == 2) pool_half_t<2>(tb, oct, V, PO); else pool_half_t<3>(tb, oct, V, PO);
}
__device__ __forceinline__ void pool_run(int kg, int t0, int oct, const bf16* V, bf16* PO) {
#pragma unroll 1
    for (int hh = 0; hh < 2; ++hh) pool_half(kg, t0 + 8 * hh, oct, V, PO);
}
__device__ __forceinline__ void pool_tile_workers(int bx, int wave, int lane, const bf16* V, bf16* PO) {
    const int kg = bx >> 6, pm = bx & 63;
#pragma unroll 1
    for (int h = (wave - 1) * 64 + lane; h < 1024; h += 448) pool_half(kg, 256 * pm + 8 * (h >> 5), kg * 32 + (h & 31), V, PO);
}

__device__ __forceinline__ void pool_item(int idx, const bf16* V, bf16* PO) { const int kg = (idx >> 6) & 3; pool_run(kg, (2 * (idx >> 8) + ((idx >> 5) & 1)) * 16, kg * 32 + (idx & 31), V, PO); }
__device__ __forceinline__ void s5_scan_merged(int u, LAS unsigned char* lds, int wave, int lane, const float* SLOC, const float* LT, bf16* AG, unsigned long long* XE, unsigned* XF, unsigned* tmo,
                                               const bf16* V, bf16* PO) {
    const int g = u >> 2, pmm = u & 3, p = lane, sg = wave, c0 = pmm * 256;
    const float Lr = LT[(g * 64 + p) * 2], Li = LT[(g * 64 + p) * 2 + 1];
    const float* base = SLOC + ((size_t)(g * NCHK + c0 + sg * 32)) * 128 + p;
    float ar[32], ai[32];
#pragma unroll
    for (int k = 0; k < 32; ++k) { ar[k] = base[(size_t)k * 128]; ai[k] = base[(size_t)k * 128 + 64]; }
    float sr = 0.f, si = 0.f;
#pragma unroll
    for (int k = 0; k < 32; ++k) { const float tr = ar[k], ti = ai[k]; ar[k] = sr; ai[k] = si; const float nr = Lr * sr - Li * si + tr, ni = Lr * si + Li * sr + ti; sr = nr; si = ni; }
    LAS float* End = (LAS float*)lds;
    End[(sg * 64 + p) * 2] = sr; End[(sg * 64 + p) * 2 + 1] = si;
    __syncthreads();
    float Mr = Lr, Mi = Li;
#pragma unroll
    for (int q = 0; q < 5; ++q) { const float nr = Mr * Mr - Mi * Mi, ni = 2.f * Mr * Mi; Mr = nr; Mi = ni; }
    float cr = 0.f, ci = 0.f;
    for (int s2 = 0; s2 < sg; ++s2) { const float er = End[(s2 * 64 + p) * 2], ei = End[(s2 * 64 + p) * 2 + 1]; const float nr = Mr * cr - Mi * ci + er, ni = Mr * ci + Mi * cr + ei; cr = nr; ci = ni; }
    if (sg == 7) {
        const float er = Mr * cr - Mi * ci + sr, ei = Mr * ci + Mi * cr + si;
        __hip_atomic_store(XE + (size_t)u * 128 + p, (1ull << 32) | __float_as_uint(er), __ATOMIC_RELAXED, __HIP_MEMORY_SCOPE_AGENT);
        __hip_atomic_store(XE + (size_t)u * 128 + 64 + p, (1ull << 32) | __float_as_uint(ei), __ATOMIC_RELAXED, __HIP_MEMORY_SCOPE_AGENT);
    }
    float M8r = Mr, M8i = Mi;
#pragma unroll
    for (int q = 0; q < 3; ++q) { const float nr = M8r * M8r - M8i * M8i, ni = 2.f * M8r * M8i; M8r = nr; M8i = ni; }
    float Cr = 0.f, Ci = 0.f;
    if (pmm > 0) {
        unsigned long long er_[3], ei_[3]; unsigned sp = 0;
        for (;;) { bool ok = true;
#pragma unroll
            for (int j = 0; j < 3; ++j) { er_[j] = 1ull << 32; ei_[j] = 1ull << 32;
                if (j < pmm) { const unsigned long long* q = XE + (size_t)(g * 4 + j) * 128 + p; er_[j] = __hip_atomic_load(q, __ATOMIC_RELAXED, __HIP_MEMORY_SCOPE_AGENT); ei_[j] = __hip_atomic_load(q + 64, __ATOMIC_RELAXED, __HIP_MEMORY_SCOPE_AGENT); }
                ok = ok && ((unsigned)(er_[j] >> 32) == 1u) && ((unsigned)(ei_[j] >> 32) == 1u); }
            if (__all(ok ? 1 : 0)) break;
            __builtin_amdgcn_s_sleep(2); if (++sp > (1u << 20)) { if (lane == 0) __hip_atomic_store(tmo, 1u, __ATOMIC_RELAXED, __HIP_MEMORY_SCOPE_AGENT); break; } }
#pragma unroll
        for (int j = 0; j < 3; ++j) if (j < pmm) { const float er = __uint_as_float((unsigned)er_[j]), ei = __uint_as_float((unsigned)ei_[j]);
            const float nr = M8r * Cr - M8i * Ci + er, ni = M8r * Ci + M8i * Cr + ei; Cr = nr; Ci = ni; }
    }
    for (int q = 0; q < sg; ++q) { const float nr = Mr * Cr - Mi * Ci, ni = Mr * Ci + Mi * Cr; Cr = nr; Ci = ni; }
    cr += Cr; ci += Ci;
    bf16* dst = AG + ((size_t)(g * NCHK + c0 + sg * 32)) * AGK + 256 + p;
#pragma unroll
    for (int k = 0; k < 32; ++k) { dst[(size_t)k * AGK] = (bf16)f2bf(ar[k] + cr); dst[(size_t)k * AGK + 64] = (bf16)f2bf(ai[k] + ci); const float nr = Lr * cr - Li * ci, ni = Lr * ci + Li * cr; cr = nr; ci = ni; }
    asm volatile("s_waitcnt vmcnt(0)" ::: "memory");
    __syncthreads();
}

struct Args { const float* in[22]; float* out; unsigned char* ws; int ph_lo, ph_hi, li, pad; };
__global__ void __launch_bounds__(NWAVES * 64, 2) mk_fwd(Args args) {
    extern __shared__ __attribute__((aligned(16))) unsigned char lds_raw[];
    LAS unsigned char* lds = (LAS unsigned char*)lds_raw;
    volatile LAS unsigned* MISC = (volatile LAS unsigned*)(lds + MISC_OFF);
    const int tid = threadIdx.x, lane = tid & 63, wave = __builtin_amdgcn_readfirstlane(tid >> 6);
    const int G = gridDim.x, bx = blockIdx.x;
    unsigned char* ws = args.ws;
    unsigned* ctl = (unsigned*)(ws + WS_CTL);
    const float* x = args.in[0]; float* out = args.out;
    bf16* WIN = (bf16*)(ws + WS_WIN); bf16* WGLU = (bf16*)(ws + WS_WGLU); bf16* WPOOL = (bf16*)(ws + WS_WPOOL); bf16* WOUT = (bf16*)(ws + WS_WOUT);
    bf16* WGU = (bf16*)(ws + WS_WGU); bf16* WDOWN = (bf16*)(ws + WS_WDOWN); bf16* BTA = (bf16*)(ws + WS_BTA); bf16* BTB = (bf16*)(ws + WS_BTB);
    bf16* XB = (bf16*)(ws + WS_XB); bf16* AG = (bf16*)(ws + WS_AG); bf16* VB = (bf16*)(ws + WS_V); float* SLOC = (float*)(ws + WS_SLOC);
    bf16* GBUF = (bf16*)(ws + WS_GBUF); bf16* POOLED = (bf16*)(ws + WS_POOLED); bf16* FFB = (bf16*)(ws + WS_FF); bf16* MIXED = (bf16*)(ws + WS_MIXED);
    float* BIASP = (float*)(ws + WS_BIASP); float* LT = (float*)(ws + WS_LT); float* RSTD1 = (float*)(ws + WS_RSTD1);
    float* ROWSS2 = (float*)(ws + WS_CTL + CTL_ROWSS2); float* ROWSS3 = (float*)(ws + WS_CTL + CTL_ROWSS3);

    for (int u = tid; u < (LDS_BYTES - LDSCTL_OFF) / 4; u += NWAVES * 64) ((LAS unsigned*)(lds + LDSCTL_OFF))[u] = 0u;
    __syncthreads();
    XcdBarrier bar; bar.bar = ctl + CW_BAR; bar.x = 0; bar.st = nullptr;
    if (!MK_PER_PHASE) bar = xcd_barrier_post(ctl + CW_BAR, MISC + 8);
    constexpr int NITEMS = 32 * 64 + 16 * 32 + 4 * 32 + 32 * 64 + 2 * 32 * 176 + 88 * 64, IT_WIN = 2048, IT_POOLGLU = 2688, IT_WOUT = 4736, IT_WGU = 16000;
    const bool defer = !MK_PER_PHASE && G == 256;
    const int NWORK = G * (NWAVES - 1);
    int dnext = IT_WIN + bx * (NWAVES - 1) + (wave - 1);
    unsigned bar_seq = 0;
#define DEFER_LIMIT(seam) ((seam) < 1 ? IT_WIN : (seam) < 5 ? IT_POOLGLU : (seam) == 5 ? IT_WOUT : (seam) == 6 ? IT_WGU : NITEMS)
#define GRID_BAR(seam) do { if (MK_PER_PHASE) { if (tid == 0) __hip_atomic_store(ctl + CW_TMO, 0xBADBA0u | (unsigned)(seam), __ATOMIC_RELAXED, __HIP_MEMORY_SCOPE_AGENT); } else { \
        LAS float* scr_ = (LAS float*)(lds + RING_OFF + wave * 16384); \
        if (defer && wave != 0) { const int lim_ = DEFER_LIMIT(seam); while (dnext < lim_) { titem_run(dnext, args.in, WIN, WGLU, WPOOL, WOUT, WGU, WDOWN, scr_, lane); dnext += NWORK; } } \
        asm volatile("s_waitcnt vmcnt(0)" ::: "memory"); __syncthreads(); ++bar_seq; \
        if (wave == 0) { if (threadIdx.x == 0) { xcd_barrier_protocol(bar); MISC[12] = bar_seq; } } \
        else if (defer) { if ((seam) == 4) pool_tile_workers(bx, wave, lane, VB, POOLED);     \
            while (MISC[12] != bar_seq) { if (dnext < NITEMS) { titem_run(dnext, args.in, WIN, WGLU, WPOOL, WOUT, WGU, WDOWN, scr_, lane); dnext += NWORK; } else __builtin_amdgcn_s_sleep(8); } } \
        asm volatile("s_waitcnt vmcnt(0)" ::: "memory"); __syncthreads(); } } while (0)
    const int cu = defer ? ((bx & 7) * 32 + (bx >> 3)) : bx;
    const int lo = args.ph_lo, hi = args.ph_hi;
#define IN(k) (lo <= (k) && (k) < hi)
#define BOTH(k) (IN(k) && IN((k) + 1))
#define REPS(k) (((MK_PROBE_MASK >> (k)) & 1) ? 2 : 1)
    float* const DUMMY_OUT = (float*)(ws + 342 * MiB); float* const DUMMY_SS = (float*)(ws + 470 * MiB); bf16* const DUMMY_HB = (bf16*)(ws + 406 * MiB);

    if (IN(0)) for (int rep = REPS(0); rep > 0; --rep) {
        LAS float* scr = (LAS float*)(lds + RING_OFF + wave * 16384);
        const int gw = bx * NWAVES + wave, NGW = G * NWAVES;
        if (defer) {
            if ((bx & 3) == 3) s5_tables_group(bx >> 2, lds, tid, args.in[3], args.in[4], args.in[5], args.in[6], args.in[7], args.in[8], args.in[9], args.in[10], BTA, BTB, LT);
            else { const int nw = (bx - (bx >> 2)) * NWAVES + wave, NNW = (G - NGRP) * NWAVES;
                for (int m = nw; m < SEQ / 2; m += NNW) x_rows2_to_bf16(x, XB, RSTD1, 2 * m, 2 * m + 1, lane);
                for (int it = nw; it < IT_WIN; it += NNW) titem_run(it, args.in, WIN, WGLU, WPOOL, WOUT, WGU, WDOWN, scr, lane); }
        } else {
            for (int g = bx; g < NGRP; g += G) s5_tables_group(g, lds, tid, args.in[3], args.in[4], args.in[5], args.in[6], args.in[7], args.in[8], args.in[9], args.in[10], BTA, BTB, LT);
            for (int m = gw; m < SEQ / 2; m += NGW) x_rows2_to_bf16(x, XB, RSTD1, 2 * m, 2 * m + 1, lane);
            for (int it = gw; it < NITEMS; it += NGW) titem_run(it, args.in, WIN, WGLU, WPOOL, WOUT, WGU, WDOWN, scr, lane);
        }
        if (bx == 0) for (int i = tid; i < 1024; i += NWAVES * 64) BIASP[i] = args.in[14][i] * args.in[15][i];
        for (int i = bx * (NWAVES * 64) + tid; i < 256 * 128; i += G * NWAVES * 64) ((unsigned long long*)(ws + WS_XE))[i] = 0ull;
        if (BOTH(0) || rep > 1) GRID_BAR(0);
    }
    if (IN(1)) for (int rep = REPS(1); rep > 0; --rep) {
        pg8::Gemm g{XB, WIN, DM, DM, DM, 128}; pg8::StaticOrder S; S.init(SEQ, DM, G, bx, DM, DM);
        pg8::EpiProj E{AG, VB, RSTD1};
        pg8::gemm_phase<pg8::EpiProj, pg8::StaticOrder, PG8_ALIGN, PG8_SP2>(lds + RING_OFF, g, S, E);
        if (BOTH(1) || rep > 1) GRID_BAR(1);
    }
    if (IN(2)) for (int rep = REPS(2); rep > 0; --rep) {
        pg8::Gemm g{AG, BTA, AGK, 256, 256, 0}; pg8::GroupOrder S{NGRP * 4, G, cu, AGK, 4, (long long)128 * 256};
        pg8::EpiSloc E{SLOC};
        pg8::gemm_phase<pg8::EpiSloc, pg8::GroupOrder, PG8_ALIGN, PG8_SP2>(lds + RING_OFF, g, S, E);
        if (!defer && (BOTH(2) || rep > 1)) GRID_BAR(2);
    }
    if (IN(3)) for (int rep = REPS(3); rep > 0; --rep) {
        if (defer) s5_scan_merged(cu, lds, wave, lane, SLOC, LT, AG, (unsigned long long*)(ws + WS_XE), ctl + CW_XF, ctl + CW_TMO, VB, POOLED);
        else { for (int w = bx; w < 256; w += G) s5_scan_item(w, lds, tid, SLOC, LT, AG);
               for (int idx = bx * (NWAVES * 64) + tid; idx < 131072; idx += G * NWAVES * 64) pool_item(idx, VB, POOLED); }
        if (!defer && (BOTH(3) || rep > 1)) GRID_BAR(3);
    }
    if (IN(4)) for (int rep = REPS(4); rep > 0; --rep) {
        { pg8::Gemm g{AG, BTB, AGK, AGK, AGK, 128}; pg8::GroupOrder S{NGRP * 4, G, cu, AGK, 4, (long long)256 * AGK};
          pg8::EpiS5Out E{GBUF};
          pg8::gemm_phase<pg8::EpiS5Out, pg8::GroupOrder, PG8_ALIGN, PG8_SP2>(lds + RING_OFF, g, S, E); }
        if (!defer) { pg8::Gemm g{POOLED, WPOOL, 1024, 1024, 256, 128}; pg8::PoolOrder S{256, G, bx};
          pg8::EpiPoolOut E{MIXED, BIASP};
          pg8::gemm_phase<pg8::EpiPoolOut, pg8::PoolOrder, PG8_ALIGN, PG8_SP2>(lds + RING_OFF, g, S, E); }
        if (BOTH(4) || rep > 1) GRID_BAR(4);
    }
    if (IN(5)) for (int rep = REPS(5); rep > 0; --rep) {
        pg8::Gemm g{GBUF, WGLU, SSMW, SSMW, SSMW, 128}; pg8::StaticOrder S; S.init(SEQ, SSMW, G, bx, SSMW, SSMW);
        pg8::EpiGlu E{MIXED, GBUF, args.in[12]};
        if (defer) { pg8::GluPoolOrder S2{S, bx, (long long)(POOLED - GBUF), (long long)(WPOOL - WGLU)}; pg8::EpiGluPool E2{E, pg8::EpiPoolOut{MIXED, BIASP}};
            pg8::gemm_phase<pg8::EpiGluPool, pg8::GluPoolOrder, PG8_ALIGN, PG8_SP2>(lds + RING_OFF, g, S2, E2); }
        else pg8::gemm_phase<pg8::EpiGlu, pg8::StaticOrder, PG8_ALIGN, PG8_SP2>(lds + RING_OFF, g, S, E);
        if (BOTH(5) || rep > 1) GRID_BAR(5);
    }
    if (IN(6)) for (int rep = REPS(6); rep > 0; --rep) {
        pg8::Gemm g{MIXED, WOUT, DM, DM, DM, 128}; pg8::StaticOrder S; S.init(SEQ, DM, G, bx, DM, DM);
        pg8::EpiResidA E{XB, rep > 1 ? DUMMY_SS : ROWSS2};
        pg8::gemm_phase<pg8::EpiResidA, pg8::StaticOrder, PG8_ALIGN, PG8_SP2>(lds + RING_OFF, g, S, E);
        if (BOTH(6) || rep > 1) GRID_BAR(6);
    }
    if (IN(7)) for (int rep = REPS(7); rep > 0; --rep) {
        pg8::Gemm g{XB, WGU, DM, DM, DM, 128}; pg8::StaticOrder S; S.init(SEQ, 2 * DFF, G, bx, DM, DM);
        pg8::EpiSwiglu E{FFB, ROWSS2};
        pg8::gemm_phase<pg8::EpiSwiglu, pg8::StaticOrder, PG8_ALIGN, PG8_SP2>(lds + RING_OFF, g, S, E);
        if (BOTH(7) || rep > 1) GRID_BAR(7);
    }
    if (IN(8)) {
        const bool bad = !MK_PER_PHASE && ((__hip_atomic_load(ctl + CW_BAR + XB_TMO, __ATOMIC_RELAXED, __HIP_MEMORY_SCOPE_AGENT) | __hip_atomic_load(ctl + CW_TMO, __ATOMIC_RELAXED, __HIP_MEMORY_SCOPE_AGENT)) != 0u);
        static_assert(PG8_ALIGN, "EpiFinal waits for all 64 waves of its row panel inside the epilogue: both half-workgroups must run their epilogues together (ALIGN_EPI), else the trailing half can never arrive");
        pg8::Gemm g{FFB, WDOWN, DFF, DFF, DFF, 128}; pg8::PanelOrder S{bx, DFF, DFF};
        pg8::EpiFinal E{XB, out, ROWSS3, ctl + CW_PANEL, ctl + CW_TMO, args.in[21]};
        if (G == 256 && !bad) pg8::gemm_phase<pg8::EpiFinal, pg8::PanelOrder, PG8_ALIGN, PG8_SP2>(lds + RING_OFF, g, S, E);
        else { const float qn = __builtin_nanf(""); for (size_t i = (size_t)bx * (NWAVES * 64) + tid; i < (size_t)SEQ * DM / 4; i += (size_t)G * NWAVES * 64) ((f32x4*)out)[i] = (f32x4){qn, qn, qn, qn}; }
    }
#undef IN
#undef BOTH
}

extern "C" void kernel_launch(void* const* d_in, const int* in_sizes, int n_in, void* d_out, int out_size, void* d_ws, size_t ws_size, hipStream_t stream) {
    static int grid = 0;
    if (grid == 0) {
        if (n_in != 22 || in_sizes[0] != SEQ * DM || out_size != SEQ * DM || ws_size < (MK_PROBE_MASK ? 471 * MiB : WS_END)) { fprintf(stderr, "kernel_launch: unexpected problem (n_in %d, in0 %d, out %d, ws %zu); nothing launched\n", n_in, n_in > 0 ? in_sizes[0] : -1, out_size, ws_size); grid = -1; return; }
        int dev = 0, cus = 0, per_cu = 0;
        if (hipGetDevice(&dev) != hipSuccess || hipDeviceGetAttribute(&cus, hipDeviceAttributeMultiprocessorCount, dev) != hipSuccess) { grid = -1; return; }
        if (hipFuncSetAttribute((const void*)mk_fwd, hipFuncAttributeMaxDynamicSharedMemorySize, LDS_BYTES) != hipSuccess) { fprintf(stderr, "kernel_launch: hipFuncSetAttribute failed\n"); grid = -1; return; }
        if (hipOccupancyMaxActiveBlocksPerMultiprocessor(&per_cu, (const void*)mk_fwd, NWAVES * 64, LDS_BYTES) != hipSuccess || per_cu < 1) { fprintf(stderr, "kernel_launch: occupancy query says %d blocks per CU\n", per_cu); }
        (void)hipGetLastError();
        grid = cus < 256 ? cus : 256;
    }
    if (grid < 0) return;
    (void)hipMemsetAsync((char*)d_ws + WS_CTL, 0, CTL_ZERO_BYTES, stream);
    Args a{};
    for (int i = 0; i < 22; ++i) a.in[i] = (const float*)d_in[i];
    a.out = (float*)d_out; a.ws = (unsigned char*)d_ws;
#if MK_PER_PHASE
    for (int p = 0; p < N_PHASES; ++p) { a.ph_lo = p; a.ph_hi = p + 1; a.li = p; hipLaunchKernelGGL(mk_fwd, dim3(grid), dim3(NWAVES * 64), LDS_BYTES, stream, a); }
#else
    a.ph_lo = 0; a.ph_hi = N_PHASES; a.li = 0;
    hipLaunchKernelGGL(mk_fwd, dim3(grid), dim3(NWAVES * 64), LDS_BYTES, stream, a);
#endif
}
```

```cpp
#include <hip/hip_runtime.h>
#include <cstdio>
#include <cstdint>

#ifndef MK_PROBE_MASK
#define MK_PROBE_MASK 0
#endif
#ifndef MK_PER_PHASE
#define MK_PER_PHASE 0
#endif

namespace pg8 {
#define PG8_LAS __attribute__((address_space(3)))
typedef unsigned short bf16_t;
typedef short bf16x8 __attribute__((ext_vector_type(8)));
typedef float f32x4 __attribute__((ext_vector_type(4)));
typedef float f32x2 __attribute__((ext_vector_type(2)));
typedef unsigned u32x4 __attribute__((ext_vector_type(4)));
constexpr int BM = 256, BK = 64, HALF = 128, HTB = HALF * BK * 2, STAGE_BYTES = 8 * HTB, NXCD = 8, WGM = 8;

__host__ __device__ __forceinline__ int lds_byte(int r, int c) { const int st = (r >> 4) * 2 + (c >> 5), rr = r & 15, cc = c & 31, ob = rr * 64 + cc * 2; return st * 1024 + (ob ^ (((ob >> 9) & 1) << 5)); }
__host__ __device__ __forceinline__ void stage_rc(int b, int& R, int& C) { const int st = b / 1024, sb = b % 1024, swz = sb ^ (((sb >> 9) & 1) << 5); R = (st >> 1) * 16 + swz / 64; C = (st & 1) * 32 + (swz % 64) / 2; }
__host__ __device__ __forceinline__ int perm32(int rho) { const int n = rho >> 4, i = rho & 15; return 8 * (i >> 2) + 4 * n + (i & 3); }

struct Unit { int pm, pn, ntk, kind; long long aoff, boff; };
struct Gemm { const bf16_t* A; const bf16_t* Bt; int lda, ldb, K, hsB; };

struct StaticOrder {
    int nM, nN, nwg, G, c, lda, ldb, wgm;
    __device__ void init(int M, int N, int G_, int c_, int lda_, int ldb_, int wgm_ = WGM) { nM = M / BM; nN = N / BM; nwg = nM * nN; G = G_; c = c_; lda = lda_; ldb = ldb_; wgm = wgm_; }
    __device__ bool next(int i, Unit& u) const {
        const long L = (long)i * G + c; if (L >= nwg) return false;
        int wgid = (int)L; { const int q = nwg / NXCD, r = nwg % NXCD, xcd = wgid % NXCD, off = wgid / NXCD; wgid = (xcd < r ? xcd * (q + 1) : r * (q + 1) + (xcd - r) * q) + off; }
        const int nig = wgm * nN, gid = wgid / nig, fm = gid * wgm, gsz = (nM - fm) < wgm ? (nM - fm) : wgm;
        u.pm = fm + ((wgid % nig) % gsz); u.pn = (wgid % nig) / gsz; u.ntk = 0; u.kind = 0;
        u.aoff = (long long)u.pm * BM * lda; u.boff = (long long)u.pn * BM * ldb; return true;
    }
    __device__ __forceinline__ void a_ready(const Unit&) const {}
    __device__ __forceinline__ void done(const Unit&) const {}
};
struct GroupOrder {
    int n, G, c, lda, per; long long bstride;
    __device__ bool next(int i, Unit& u) const { const int idx = i * G + c; if (idx >= n) return false; u.pm = idx; u.pn = 0; u.ntk = 0; u.kind = 0; u.aoff = (long long)idx * BM * lda; u.boff = (long long)(idx / per) * bstride; return true; }
    __device__ __forceinline__ void a_ready(const Unit&) const {}
    __device__ __forceinline__ void done(const Unit&) const {}
};
struct PoolOrder {
    int n, G, c;
    __device__ bool next(int i, Unit& u) const { const int idx = i * G + c; if (idx >= n) return false; u.pm = idx & 63; u.pn = idx >> 6; u.ntk = 0; u.kind = 0; u.aoff = (long long)u.pm * BM * 1024 + u.pn * 256; u.boff = (long long)u.pn * 256 * 1024; return true; }
    __device__ __forceinline__ void a_ready(const Unit&) const {}
    __device__ __forceinline__ void done(const Unit&) const {}
};

struct GluPoolOrder {
    StaticOrder so; int c; long long a1, b1;
    __device__ bool next(int i, Unit& u) const { if (i == 0) return so.next(0, u); if (i > 1) return false;
        u.pm = c & 63; u.pn = c >> 6; u.ntk = 4; u.kind = 1; u.aoff = a1 + (long long)u.pm * BM * 1024 + u.pn * 256; u.boff = b1 + (long long)u.pn * 256 * 1024; return true; }
    __device__ __forceinline__ void a_ready(const Unit&) const {}
    __device__ __forceinline__ void done(const Unit&) const {}
};
struct PanelOrder {
    int c, lda, ldb;
    __device__ bool next(int i, Unit& u) const { if (i >= 2) return false; const int xcd = c & 7, local = c >> 3; u.pm = xcd * 8 + i * 4 + (local & 3); u.pn = local >> 2; u.ntk = 0; u.kind = 0;
        u.aoff = (long long)u.pm * BM * lda; u.boff = (long long)u.pn * BM * ldb; return true; }
    __device__ __forceinline__ void a_ready(const Unit&) const {}
    __device__ __forceinline__ void done(const Unit&) const {}
};
__device__ __forceinline__ unsigned cvt_pk_bf16(float lo, float hi) { unsigned r; asm volatile("v_cvt_pk_bf16_f32 %0, %1, %2" : "=v"(r) : "v"(lo), "v"(hi)); return r; }
__device__ __forceinline__ f32x2 gelu_pk(f32x2 v) {
    const f32x2 av = __builtin_elementwise_abs(v), d = av * 0.2316418882f + 1.0f;
    f32x2 t; t.x = __builtin_amdgcn_rcpf(d.x); t.y = __builtin_amdgcn_rcpf(d.y);
    f32x2 q = t * 0.5307027145f + (-0.7265760135f); q = q * t + 0.7107068705f; q = q * t + (-0.142248368f); q = q * t + 0.127414796f; q = q * t;
    const f32x2 s = (v * v) * (-0.72134752044f);
    f32x2 e; e.x = __builtin_amdgcn_exp2f(s.x); e.y = __builtin_amdgcn_exp2f(s.y);
    const f32x2 m = v * (q * e), r = v - m;
    f32x2 o; o.x = v.x < 0.f ? m.x : r.x; o.y = v.y < 0.f ? m.y : r.y; return o;
}
__device__ __forceinline__ float sigmoidf_fast(float z) { return __builtin_amdgcn_rcpf(1.0f + __builtin_amdgcn_exp2f(z * -1.4426950408889634f)); }
__device__ __forceinline__ float bf_lo(unsigned w) { return __uint_as_float(w << 16); }
__device__ __forceinline__ float bf_hi(unsigned w) { return __uint_as_float(w & 0xffff0000u); }

struct EpiProj {
    static constexpr bool PERM = true, AFTER_DRAIN = false;
    bf16_t* AG; bf16_t* V; const float* rstd;
    __device__ __forceinline__ void operator()(const f32x4 (&acc)[2][2][4][2], const Unit& u, int wr, int wc, int fr, int fq) const {
        const int row0 = u.pm * BM + wr * 64 + fr, colt = u.pn * BM + wc * 32 + 8 * fq;
        float rsv[2][4];
#pragma unroll
        for (int ai = 0; ai < 2; ++ai)
#pragma unroll
            for (int m = 0; m < 4; ++m) rsv[ai][m] = rstd[row0 + ai * HALF + m * 16];
#pragma unroll
        for (int ai = 0; ai < 2; ++ai)
#pragma unroll
            for (int m = 0; m < 4; ++m) { const int r = row0 + ai * HALF + m * 16; const float rs = rsv[ai][m];
#pragma unroll
                for (int bj = 0; bj < 2; ++bj) { const int c0 = colt + bj * HALF; const f32x4 v0 = acc[ai][bj][m][0] * rs, v1 = acc[ai][bj][m][1] * rs;
                    u32x4 w; w.x = cvt_pk_bf16(v0[0], v0[1]); w.y = cvt_pk_bf16(v0[2], v0[3]); w.z = cvt_pk_bf16(v1[0], v1[1]); w.w = cvt_pk_bf16(v1[2], v1[3]);
                    bf16_t* dst;
                    if (u.pn < 4) { const int g = c0 >> 4, h0 = c0 & 15; dst = AG + ((size_t)(g * 1024 + (r >> 4)) * 384 + (r & 15) * 16 + h0); }
                    else dst = V + (size_t)r * 1024 + (c0 - 1024);
                    *(u32x4*)dst = w; } }
    }
};
struct EpiSloc {
    static constexpr bool PERM = false, AFTER_DRAIN = false;
    float* S;
    __device__ __forceinline__ void operator()(const f32x4 (&acc)[2][2][4][2], const Unit& u, int wr, int wc, int fr, int fq) const {
        const int row0 = u.pm * BM + wr * 64 + fr, col0 = wc * 32 + 4 * fq;
#pragma unroll
        for (int ai = 0; ai < 2; ++ai)
#pragma unroll
            for (int m = 0; m < 4; ++m) { float* rowp = S + (size_t)(row0 + ai * HALF + m * 16) * 128 + col0;
#pragma unroll
                for (int n = 0; n < 2; ++n) *(f32x4*)(rowp + n * 16) = acc[ai][0][m][n]; }
    }
};
struct EpiS5Out {
    static constexpr bool PERM = true, AFTER_DRAIN = false;
    bf16_t* GB;
    __device__ __forceinline__ void operator()(const f32x4 (&acc)[2][2][4][2], const Unit& u, int wr, int wc, int fr, int fq) const {
        const int R0 = u.pm * BM + wr * 64 + fr;
#pragma unroll
        for (int ai = 0; ai < 2; ++ai)
#pragma unroll
            for (int m = 0; m < 4; ++m) { const int R = R0 + ai * HALF + m * 16, g = R >> 10, c = R & 1023;
#pragma unroll
                for (int bj = 0; bj < 2; ++bj) { const int cc = bj * HALF + wc * 32 + 8 * fq, i = cc >> 4, h0 = cc & 15; const f32x4 v0 = acc[ai][bj][m][0], v1 = acc[ai][bj][m][1];
                    const f32x2 a = gelu_pk((f32x2){v0[0], v0[1]}), b = gelu_pk((f32x2){v0[2], v0[3]}), cq = gelu_pk((f32x2){v1[0], v1[1]}), d = gelu_pk((f32x2){v1[2], v1[3]});
                    u32x4 w; w.x = cvt_pk_bf16(a.x, a.y); w.y = cvt_pk_bf16(b.x, b.y); w.z = cvt_pk_bf16(cq.x, cq.y); w.w = cvt_pk_bf16(d.x, d.y);
                    *(u32x4*)(GB + (size_t)(c * 16 + i) * 1024 + g * 16 + h0) = w; } }
    }
};
struct EpiPoolOut {
    static constexpr bool PERM = true, AFTER_DRAIN = false;
    bf16_t* MX; const float* biasp;
    __device__ __forceinline__ void operator()(const f32x4 (&acc)[2][2][4][2], const Unit& u, int wr, int wc, int fr, int fq) const {
        const int row0 = u.pm * BM + wr * 64 + fr, col0 = u.pn * 256 + wc * 32 + 8 * fq;
        f32x4 bv[2][2];
#pragma unroll
        for (int bj = 0; bj < 2; ++bj)
#pragma unroll
            for (int n = 0; n < 2; ++n) bv[bj][n] = *(const f32x4*)(biasp + col0 + bj * HALF + 4 * n);
#pragma unroll
        for (int ai = 0; ai < 2; ++ai)
#pragma unroll
            for (int m = 0; m < 4; ++m) { bf16_t* rowp = MX + (size_t)(row0 + ai * HALF + m * 16) * 2048 + 1024 + col0;
#pragma unroll
                for (int bj = 0; bj < 2; ++bj) { const f32x4 v0 = acc[ai][bj][m][0] + bv[bj][0], v1 = acc[ai][bj][m][1] + bv[bj][1];
                    u32x4 w; w.x = cvt_pk_bf16(v0[0], v0[1]); w.y = cvt_pk_bf16(v0[2], v0[3]); w.z = cvt_pk_bf16(v1[0], v1[1]); w.w = cvt_pk_bf16(v1[2], v1[3]);
                    *(u32x4*)(rowp + bj * HALF) = w; } }
    }
};
struct EpiGlu {
    static constexpr bool PERM = true, AFTER_DRAIN = false;
    bf16_t* MX; const bf16_t* GB; const float* bias;
    __device__ __forceinline__ void operator()(const f32x4 (&acc)[2][2][4][2], const Unit& u, int wr, int wc, int fr, int fq) const {
        const int row0 = u.pm * BM + wr * 64 + fr, col0 = u.pn * BM + wc * 32 + 8 * fq;
        f32x4 bv[2][2];
#pragma unroll
        for (int bj = 0; bj < 2; ++bj)
#pragma unroll
            for (int n = 0; n < 2; ++n) bv[bj][n] = *(const f32x4*)(bias + col0 + bj * HALF + 4 * n);
#pragma unroll
        for (int ai = 0; ai < 2; ++ai) {
            u32x4 gw[4][2];
#pragma unroll
            for (int m = 0; m < 4; ++m)
#pragma unroll
                for (int bj = 0; bj < 2; ++bj) gw[m][bj] = *(const u32x4*)(GB + (size_t)(row0 + ai * HALF + m * 16) * 1024 + col0 + bj * HALF);
#pragma unroll
            for (int m = 0; m < 4; ++m) { const size_t r = (size_t)(row0 + ai * HALF + m * 16);
#pragma unroll
                for (int bj = 0; bj < 2; ++bj) { const u32x4 g4 = gw[m][bj];
                    const f32x4 z0 = acc[ai][bj][m][0] + bv[bj][0], z1 = acc[ai][bj][m][1] + bv[bj][1];
                    const float o0 = bf_lo(g4.x) * sigmoidf_fast(z0[0]), o1 = bf_hi(g4.x) * sigmoidf_fast(z0[1]), o2 = bf_lo(g4.y) * sigmoidf_fast(z0[2]), o3 = bf_hi(g4.y) * sigmoidf_fast(z0[3]);
                    const float o4 = bf_lo(g4.z) * sigmoidf_fast(z1[0]), o5 = bf_hi(g4.z) * sigmoidf_fast(z1[1]), o6 = bf_lo(g4.w) * sigmoidf_fast(z1[2]), o7 = bf_hi(g4.w) * sigmoidf_fast(z1[3]);
                    u32x4 w; w.x = cvt_pk_bf16(o0, o1); w.y = cvt_pk_bf16(o2, o3); w.z = cvt_pk_bf16(o4, o5); w.w = cvt_pk_bf16(o6, o7);
                    *(u32x4*)(MX + r * 2048 + col0 + bj * HALF) = w; } }
            asm volatile("" ::: "memory"); }
    }
};
struct EpiGluPool {
    static constexpr bool PERM = true, AFTER_DRAIN = false;
    EpiGlu a; EpiPoolOut b;
    __device__ __forceinline__ void operator()(const f32x4 (&acc)[2][2][4][2], const Unit& u, int wr, int wc, int fr, int fq) const { if (u.kind == 0) a(acc, u, wr, wc, fr, fq); else b(acc, u, wr, wc, fr, fq); }
};
struct EpiResidA {
    static constexpr bool PERM = true, AFTER_DRAIN = false;
    bf16_t* HB; float* rowss;
    __device__ __forceinline__ void operator()(const f32x4 (&acc)[2][2][4][2], const Unit& u, int wr, int wc, int fr, int fq) const {
        const int row0 = u.pm * BM + wr * 64 + fr, col0 = u.pn * BM + wc * 32 + 8 * fq;
        u32x4 bw[2][4][2];
#pragma unroll
        for (int ai = 0; ai < 2; ++ai)
#pragma unroll
            for (int m = 0; m < 4; ++m)
#pragma unroll
                for (int bj = 0; bj < 2; ++bj) bw[ai][m][bj] = *(const u32x4*)(HB + (size_t)(row0 + ai * HALF + m * 16) * 2048 + col0 + bj * HALF);
#pragma unroll
        for (int ai = 0; ai < 2; ++ai) {
#pragma unroll
            for (int m = 0; m < 4; ++m) { const int r = row0 + ai * HALF + m * 16; const size_t off = (size_t)r * 2048 + col0; float ss = 0.f;
#pragma unroll
                for (int bj = 0; bj < 2; ++bj) { const u32x4 b4 = bw[ai][m][bj]; const f32x4 a0 = acc[ai][bj][m][0], a1 = acc[ai][bj][m][1];
                    const float h0 = bf_lo(b4.x) + a0[0], h1 = bf_hi(b4.x) + a0[1], h2 = bf_lo(b4.y) + a0[2], h3 = bf_hi(b4.y) + a0[3];
                    const float h4 = bf_lo(b4.z) + a1[0], h5 = bf_hi(b4.z) + a1[1], h6 = bf_lo(b4.w) + a1[2], h7 = bf_hi(b4.w) + a1[3];
                    ss += (h0 * h0 + h1 * h1) + (h2 * h2 + h3 * h3) + (h4 * h4 + h5 * h5) + (h6 * h6 + h7 * h7);
                    u32x4 w; w.x = cvt_pk_bf16(h0, h1); w.y = cvt_pk_bf16(h2, h3); w.z = cvt_pk_bf16(h4, h5); w.w = cvt_pk_bf16(h6, h7);
                    *(u32x4*)(HB + off + bj * HALF) = w; }
                ss += __shfl_xor(ss, 16); ss += __shfl_xor(ss, 32);
                if (fq == 0) atomicAdd(rowss + r, ss); }
            asm volatile("" ::: "memory"); }
    }
};
struct EpiFinal {
    static constexpr bool PERM = true, AFTER_DRAIN = false;
    const bf16_t* HB; float* out; float* rowss; unsigned* cnt; unsigned* tmo; const float* gain;
    __device__ __forceinline__ void operator()(f32x4 (&acc)[2][2][4][2], const Unit& u, int wr, int wc, int fr, int fq) const {
        const int row0 = u.pm * BM + wr * 64 + fr, col0 = u.pn * BM + wc * 32 + 8 * fq;
#pragma unroll
        for (int ai = 0; ai < 2; ++ai) {
            u32x4 bw[4][2];
#pragma unroll
            for (int m = 0; m < 4; ++m)
#pragma unroll
                for (int bj = 0; bj < 2; ++bj) bw[m][bj] = *(const u32x4*)(HB + (size_t)(row0 + ai * HALF + m * 16) * 2048 + col0 + bj * HALF);
#pragma unroll
            for (int m = 0; m < 4; ++m) { const int r = row0 + ai * HALF + m * 16; float ss = 0.f;
#pragma unroll
                for (int bj = 0; bj < 2; ++bj) { const u32x4 b4 = bw[m][bj];
                    const f32x4 h0 = acc[ai][bj][m][0] + (f32x4){bf_lo(b4.x), bf_hi(b4.x), bf_lo(b4.y), bf_hi(b4.y)};
                    const f32x4 h1 = acc[ai][bj][m][1] + (f32x4){bf_lo(b4.z), bf_hi(b4.z), bf_lo(b4.w), bf_hi(b4.w)};
                    ss += (h0[0] * h0[0] + h0[1] * h0[1]) + (h0[2] * h0[2] + h0[3] * h0[3]) + (h1[0] * h1[0] + h1[1] * h1[1]) + (h1[2] * h1[2] + h1[3] * h1[3]);
                    acc[ai][bj][m][0] = h0; acc[ai][bj][m][1] = h1; }
                ss += __shfl_xor(ss, 16); ss += __shfl_xor(ss, 32);
                if (fq == 0) atomicAdd(rowss + r, ss); }
            asm volatile("" ::: "memory"); }
        asm volatile("s_waitcnt vmcnt(0)" ::: "memory");
        unsigned* cw = cnt + 64 * u.pm;
        if ((fr | fq) == 0) __hip_atomic_fetch_add(cw, 1u, __ATOMIC_RELAXED, __HIP_MEMORY_SCOPE_AGENT);
        { unsigned sp = 0;
          while ((unsigned)__builtin_amdgcn_readfirstlane(__hip_atomic_load(cw, __ATOMIC_RELAXED, __HIP_MEMORY_SCOPE_AGENT)) < 64u) {
              __builtin_amdgcn_s_sleep(2);
              if (++sp > (1u << 20)) { if ((fr | fq) == 0) __hip_atomic_store(tmo, 1u, __ATOMIC_RELAXED, __HIP_MEMORY_SCOPE_AGENT); break; } } }
        f32x4 gv[2][2]; float rsv[2][4];
#pragma unroll
        for (int bj = 0; bj < 2; ++bj)
#pragma unroll
            for (int n = 0; n < 2; ++n) gv[bj][n] = *(const f32x4*)(gain + col0 + bj * HALF + 4 * n);
#pragma unroll
        for (int ai = 0; ai < 2; ++ai)
#pragma unroll
            for (int m = 0; m < 4; ++m) rsv[ai][m] = __hip_atomic_load(rowss + row0 + ai * HALF + m * 16, __ATOMIC_RELAXED, __HIP_MEMORY_SCOPE_AGENT);
#pragma unroll
        for (int ai = 0; ai < 2; ++ai)
#pragma unroll
            for (int m = 0; m < 4; ++m) { const int r = row0 + ai * HALF + m * 16; const size_t off = (size_t)r * 2048 + col0;
                const float rs = 1.0f / sqrtf(rsv[ai][m] * (1.0f / 2048.0f) + 1e-6f);
#pragma unroll
                for (int bj = 0; bj < 2; ++bj) { *(f32x4*)(out + off + bj * HALF) = acc[ai][bj][m][0] * rs * gv[bj][0]; *(f32x4*)(out + off + bj * HALF + 4) = acc[ai][bj][m][1] * rs * gv[bj][1]; } }
    }
};
struct EpiSwiglu {
    static constexpr bool PERM = true, AFTER_DRAIN = false;
    bf16_t* FF; const float* rowss;
    __device__ __forceinline__ void operator()(const f32x4 (&acc)[2][2][4][2], const Unit& u, int wr, int wc, int fr, int fq) const {
        const int row0 = u.pm * BM + wr * 64 + fr, col0 = u.pn * HALF + wc * 32 + 8 * fq;
        float rsv[2][4];
#pragma unroll
        for (int ai = 0; ai < 2; ++ai)
#pragma unroll
            for (int m = 0; m < 4; ++m) rsv[ai][m] = __hip_atomic_load(rowss + row0 + ai * HALF + m * 16, __ATOMIC_RELAXED, __HIP_MEMORY_SCOPE_AGENT);
#pragma unroll
        for (int ai = 0; ai < 2; ++ai)
#pragma unroll
            for (int m = 0; m < 4; ++m) { const int r = row0 + ai * HALF + m * 16;
                const float rs = 1.0f / sqrtf(rsv[ai][m] * (1.0f / 2048.0f) + 1e-6f);
                const float c1 = rs * -1.4426950408889634f, c2 = rs * rs;
                f32x2 o[4];
#pragma unroll
                for (int n = 0; n < 2; ++n)
#pragma unroll
                    for (int hh = 0; hh < 2; ++hh) { const f32x2 g2 = (f32x2){acc[ai][0][m][n][2 * hh], acc[ai][0][m][n][2 * hh + 1]}, u2 = (f32x2){acc[ai][1][m][n][2 * hh], acc[ai][1][m][n][2 * hh + 1]};
                        const f32x2 z = g2 * c1; f32x2 e; e.x = __builtin_amdgcn_exp2f(z.x); e.y = __builtin_amdgcn_exp2f(z.y);
                        const f32x2 d = e + 1.0f; f32x2 q; q.x = __builtin_amdgcn_rcpf(d.x); q.y = __builtin_amdgcn_rcpf(d.y);
                        o[n * 2 + hh] = ((g2 * u2) * c2) * q; }
                u32x4 w; w.x = cvt_pk_bf16(o[0].x, o[0].y); w.y = cvt_pk_bf16(o[1].x, o[1].y); w.z = cvt_pk_bf16(o[2].x, o[2].y); w.w = cvt_pk_bf16(o[3].x, o[3].y);
                *(u32x4*)(FF + (size_t)r * 5632 + col0) = w; }
    }
};

template <class Epi, class Sched, bool ALIGN_EPI = false, bool SP2 = false>
__device__ __forceinline__ void gemm_phase(PG8_LAS unsigned char* lds, const Gemm g, const Sched& S, const Epi& E) {
    int tid = threadIdx.x; asm volatile("" : "+v"(tid));
    const int wid = __builtin_amdgcn_readfirstlane(tid >> 6), lane = tid & 63, wr = wid >> 2, wc = wid & 3, fr = lane & 15, fq = lane >> 4;
    const int ntg = g.K / BK;
    unsigned voffA[2], voffB[2];
#pragma unroll
    for (int i = 0; i < 2; ++i) { int R, C; stage_rc(tid * 16 + i * 8192, R, C); const int Rb = Epi::PERM ? ((R & ~31) + perm32(R & 31)) : R;
        voffA[i] = (unsigned)(R * g.lda + C) * 2u; voffB[i] = (unsigned)(Rb * g.ldb + C) * 2u; }
    const size_t kstep = (size_t)(BK * 2);
    const size_t hstepA = (size_t)HALF * g.lda * 2, hstepB = (size_t)g.hsB * g.ldb * 2;
    const unsigned ldsw = (unsigned)wid * 1024u;
    const int aoff = lds_byte(wr * 64 + fr, fq * 8), boff = lds_byte(wc * 32 + fr, fq * 8);
#define PG8_SA(b, h) (((b) * 2 + (h)) * HTB)
#define PG8_SB(b, h) ((4 + (b) * 2 + (h)) * HTB)
#define PG8_STAGE(bufoff, gbase, voff) do { _Pragma("unroll") for (int _i = 0; _i < 2; ++_i) \
        __builtin_amdgcn_global_load_lds((const unsigned*)((const char*)(gbase) + (voff)[_i]), (PG8_LAS unsigned*)(lds + (bufoff) + ldsw + _i * 8192), 16, 0, 0); } while (0)
#define PG8_LDA(dst, b, h) do { _Pragma("unroll") for (int m = 0; m < 4; ++m) _Pragma("unroll") for (int k = 0; k < 2; ++k) dst[m][k] = *(const PG8_LAS bf16x8*)(lds + PG8_SA(b, h) + aoff + m * 2048 + k * 1024); } while (0)
#define PG8_LDB(dst, b, h) do { _Pragma("unroll") for (int n = 0; n < 2; ++n) _Pragma("unroll") for (int k = 0; k < 2; ++k) dst[n][k] = *(const PG8_LAS bf16x8*)(lds + PG8_SB(b, h) + boff + n * 2048 + k * 1024); } while (0)
#define PG8_MMA(ai, bj, At, Bt) do { __builtin_amdgcn_s_setprio(1); _Pragma("unroll") for (int m = 0; m < 4; ++m) _Pragma("unroll") for (int n = 0; n < 2; ++n) _Pragma("unroll") for (int k = 0; k < 2; ++k) \
        acc[ai][bj][m][n] = __builtin_amdgcn_mfma_f32_16x16x32_bf16(Bt[n][k], At[m][k], acc[ai][bj][m][n], 0, 0, 0); __builtin_amdgcn_s_setprio(0); } while (0)
#define PG8_WAIT_V(n) asm volatile("s_waitcnt vmcnt(" #n ")" ::: "memory")
#define PG8_WAIT_L(n) asm volatile("s_waitcnt lgkmcnt(" #n ")" ::: "memory")
#define PG8_BAR __builtin_amdgcn_s_barrier()
#define PG8_SCHED __builtin_amdgcn_sched_barrier(0)
    Unit cur, nxt; int ui = 0;
    if (!S.next(0, cur)) return;
    f32x4 acc[2][2][4][2];
#pragma unroll
    for (int a = 0; a < 2; ++a)
#pragma unroll
        for (int b = 0; b < 2; ++b)
#pragma unroll
            for (int m = 0; m < 4; ++m)
#pragma unroll
                for (int n = 0; n < 2; ++n) acc[a][b][m][n] = (f32x4){0.f, 0.f, 0.f, 0.f};
    bf16x8 At[4][2], B0[2][2], B1[2][2];
    const char* cA = (const char*)g.A + cur.aoff * 2; const char* cB = (const char*)g.Bt + cur.boff * 2;
    S.a_ready(cur);
    if constexpr (SP2) {
        PG8_STAGE(PG8_SB(0, 0), cB, voffB); PG8_STAGE(PG8_SB(0, 1), cB + hstepB, voffB); PG8_STAGE(PG8_SA(0, 0), cA, voffA); PG8_STAGE(PG8_SA(0, 1), cA + hstepA, voffA);
        if (wr == 1) PG8_BAR;
        PG8_WAIT_V(2); PG8_BAR;
        PG8_STAGE(PG8_SB(1, 0), cB + kstep, voffB); PG8_STAGE(PG8_SA(1, 0), cA + kstep, voffA); PG8_STAGE(PG8_SB(1, 1), cB + hstepB + kstep, voffB);
        PG8_WAIT_V(6); PG8_BAR;
    } else {
        PG8_STAGE(PG8_SB(0, 0), cB, voffB); PG8_STAGE(PG8_SA(0, 0), cA, voffA); PG8_STAGE(PG8_SB(0, 1), cB + hstepB, voffB); PG8_STAGE(PG8_SA(0, 1), cA + hstepA, voffA);
        if (wr == 1) PG8_BAR;
        PG8_WAIT_V(4); PG8_BAR;
        PG8_STAGE(PG8_SB(1, 0), cB + kstep, voffB); PG8_STAGE(PG8_SA(1, 0), cA + kstep, voffA); PG8_STAGE(PG8_SB(1, 1), cB + hstepB + kstep, voffB);
        PG8_WAIT_V(6); PG8_BAR;
    }
    for (;;) {
        const bool has_next = S.next(ui + 1, nxt);
        const char* nA = has_next ? (const char*)g.A + nxt.aoff * 2 : cA; const char* nB = has_next ? (const char*)g.Bt + nxt.boff * 2 : cB;
        const int nt = cur.ntk ? cur.ntk : ntg;
        for (int t = 0; t < nt; t += 2) {
            const bool last = (t == nt - 2);
            const char* a1 = cA + (size_t)(t + 1) * kstep;
            const char* a2 = last ? nA : cA + (size_t)(t + 2) * kstep; const char* b2 = last ? nB : cB + (size_t)(t + 2) * kstep;
            const char* a3 = a2 + kstep; const char* b3 = b2 + kstep;
            if (last && has_next) S.a_ready(nxt);
            if constexpr (SP2) {
            PG8_LDB(B0, 0, 0); PG8_LDB(B1, 0, 1); PG8_SCHED; PG8_LDA(At, 0, 0); PG8_STAGE(PG8_SA(1, 1), a1 + hstepA, voffA);
            PG8_WAIT_V(8); PG8_WAIT_L(0); PG8_BAR; PG8_MMA(0, 0, At, B0); PG8_MMA(0, 1, At, B1); PG8_BAR; PG8_SCHED;
            PG8_LDA(At, 0, 1); PG8_STAGE(PG8_SB(0, 0), b2, voffB); PG8_STAGE(PG8_SB(0, 1), b2 + hstepB, voffB); PG8_STAGE(PG8_SA(0, 0), a2, voffA);
            PG8_WAIT_V(8); PG8_WAIT_L(0); PG8_BAR; PG8_MMA(1, 0, At, B0); PG8_MMA(1, 1, At, B1); PG8_BAR; PG8_SCHED;
            PG8_LDB(B0, 1, 0); PG8_LDB(B1, 1, 1); PG8_SCHED; PG8_LDA(At, 1, 0); PG8_STAGE(PG8_SA(0, 1), a2 + hstepA, voffA);
            PG8_WAIT_V(8); PG8_WAIT_L(0); PG8_BAR; PG8_MMA(0, 0, At, B0); PG8_MMA(0, 1, At, B1); PG8_BAR; PG8_SCHED;
            PG8_LDA(At, 1, 1); PG8_STAGE(PG8_SB(1, 0), b3, voffB); PG8_STAGE(PG8_SB(1, 1), b3 + hstepB, voffB); PG8_STAGE(PG8_SA(1, 0), a3, voffA);
            PG8_WAIT_V(8); PG8_WAIT_L(0); PG8_BAR; PG8_MMA(1, 0, At, B0); PG8_MMA(1, 1, At, B1); PG8_BAR; PG8_SCHED;
            } else {
            PG8_LDB(B0, 0, 0); PG8_SCHED; PG8_LDA(At, 0, 0); PG8_STAGE(PG8_SA(1, 1), a1 + hstepA, voffA);
            PG8_WAIT_L(8); PG8_BAR; PG8_WAIT_L(0); PG8_MMA(0, 0, At, B0); PG8_BAR; PG8_SCHED;
            PG8_LDB(B1, 0, 1); PG8_STAGE(PG8_SB(0, 0), b2, voffB);
            PG8_BAR; PG8_WAIT_L(0); PG8_MMA(0, 1, At, B1); PG8_BAR;
            PG8_LDA(At, 0, 1); PG8_STAGE(PG8_SA(0, 0), a2, voffA);
            PG8_BAR; PG8_WAIT_L(0); PG8_MMA(1, 0, At, B0); PG8_BAR; PG8_SCHED;
            PG8_STAGE(PG8_SB(0, 1), b2 + hstepB, voffB);
            PG8_WAIT_V(6); PG8_BAR; PG8_MMA(1, 1, At, B1); PG8_BAR;
            PG8_LDB(B0, 1, 0); PG8_SCHED; PG8_LDA(At, 1, 0); PG8_STAGE(PG8_SA(0, 1), a2 + hstepA, voffA);
            PG8_WAIT_L(8); PG8_BAR; PG8_WAIT_L(0); PG8_MMA(0, 0, At, B0); PG8_BAR; PG8_SCHED;
            PG8_LDB(B1, 1, 1); PG8_STAGE(PG8_SB(1, 0), b3, voffB);
            PG8_BAR; PG8_WAIT_L(0); PG8_MMA(0, 1, At, B1); PG8_BAR;
            PG8_LDA(At, 1, 1); PG8_STAGE(PG8_SA(1, 0), a3, voffA);
            PG8_BAR; PG8_WAIT_L(0); PG8_MMA(1, 0, At, B0); PG8_BAR; PG8_SCHED;
            PG8_STAGE(PG8_SB(1, 1), b3 + hstepB, voffB);
            PG8_WAIT_V(6); PG8_BAR; PG8_MMA(1, 1, At, B1); PG8_BAR;
            }
        }
        if constexpr (ALIGN_EPI) { if (wr == 0) PG8_BAR; }
        if constexpr (!Epi::AFTER_DRAIN) { int fr2 = fr, fq2 = fq; asm volatile("" : "+v"(fr2), "+v"(fq2));
            E(acc, cur, wr, wc, fr2, fq2); S.done(cur); }
        if (!has_next) break;
#pragma unroll
        for (int a = 0; a < 2; ++a)
#pragma unroll
            for (int b = 0; b < 2; ++b)
#pragma unroll
                for (int m = 0; m < 4; ++m)
#pragma unroll
                    for (int n = 0; n < 2; ++n) acc[a][b][m][n] = (f32x4){0.f, 0.f, 0.f, 0.f};
        cur = nxt; cA = nA; cB = nB; ++ui;
        if constexpr (ALIGN_EPI) { if (wr == 1) PG8_BAR; }
    }
    PG8_WAIT_V(0);
    if constexpr (!ALIGN_EPI) { if (wr == 0) PG8_BAR; }
    PG8_BAR;
#undef PG8_SA
#undef PG8_SB
#undef PG8_STAGE
#undef PG8_LDA
#undef PG8_LDB
#undef PG8_MMA
#undef PG8_WAIT_V
#undef PG8_WAIT_L
#undef PG8_BAR
#undef PG8_SCHED
}
}

#ifndef WGM_P1
#define WGM_P1 4
#endif
#ifndef WGM_P5
#define WGM_P5 4
#endif
#ifndef WGM_P6
#define WGM_P6 4
#endif
#ifndef WGM_P7
#define WGM_P7 4
#endif
#ifndef PG8_SP2
#define PG8_SP2 true
#endif
#ifndef PG8_ALIGN
#define PG8_ALIGN true
#endif

constexpr int NWAVES = 8;
constexpr int SEQ = 16384, DM = 2048, SSMW = 1024, NGRP = 64, NST = 64, NHC = 16, DFF = 5632, TCH = 16, NCHK = SEQ / TCH, AGK = 384;
constexpr size_t MiB = 1u << 20;
constexpr size_t WS_CTL = 0, CTL_ZERO_BYTES = 1 * MiB;
constexpr size_t WS_WIN = 1 * MiB, WS_WGLU = 9 * MiB, WS_WPOOL = 406 * MiB, WS_BIASP = 11 * MiB + 512 * 1024, WS_LT = WS_BIASP + 64 * 1024, WS_RSTD1 = WS_BIASP + 128 * 1024, WS_XE = WS_BIASP + 256 * 1024;
constexpr size_t WS_WOUT = 12 * MiB, WS_WGU = 20 * MiB, WS_WDOWN = 64 * MiB, WS_BTA = 86 * MiB, WS_BTB = 90 * MiB, WS_XB = 102 * MiB;
constexpr size_t WS_AG = 166 * MiB, WS_V = 214 * MiB, WS_SLOC = 246 * MiB, WS_GBUF = 278 * MiB, WS_POOLED = 310 * MiB, WS_FF = 166 * MiB, WS_MIXED = 342 * MiB, WS_END = 408 * MiB;
static_assert(WS_FF + (size_t)SEQ * DFF * 2 <= WS_MIXED && WS_AG + (size_t)NGRP * NCHK * AGK * 2 <= WS_V && WS_BTB + (size_t)NGRP * 256 * AGK * 2 <= WS_XB && WS_WDOWN + (size_t)DM * DFF * 2 <= WS_BTA, "ws map");
constexpr int CW_TMO = 0, CW_BAR = 4096, CW_PANEL = 196608, CW_XF = 212992;
constexpr size_t CTL_ROWSS2 = 256 * 1024, CTL_ROWSS3 = 512 * 1024;
constexpr int RING_OFF = 0, RING_BYTES = 131072, LDSCTL_OFF = RING_BYTES, MISC_OFF = LDSCTL_OFF + 320, LDS_BYTES = 147456;
constexpr int N_PHASES = 9;

#define LAS __attribute__((address_space(3)))
typedef unsigned short bf16;
typedef unsigned v4u __attribute__((ext_vector_type(4)));
typedef unsigned v2u __attribute__((ext_vector_type(2)));
typedef float f32x4 __attribute__((ext_vector_type(4)));
#define LDS_WAIT() asm volatile("s_waitcnt lgkmcnt(0)" ::: "memory")
#define VM_WAIT() asm volatile("s_waitcnt vmcnt(0)" ::: "memory")
__device__ __forceinline__ unsigned f2bf(float f) { unsigned u = __builtin_bit_cast(unsigned, f); return (u + 0x7fffu + ((u >> 16) & 1u)) >> 16; }
__device__ __forceinline__ unsigned pk2(float lo, float hi) { return f2bf(lo) | (f2bf(hi) << 16); }

#define XB_TMO      128
#define XB_XCNT(j)  (256  + 64 * (j))
#define XB_XSUB(j)  (1280 + 64 * (j))
#define XB_XGEN(j)  (2304 + 64 * (j))
#define XB_TOP      3328
#define XB_TOPGEN   3392
#define XCD_BAR_WORDS 3456
#define XB_SPIN_CAP (1u << 18)
__device__ __forceinline__ unsigned xb_ld(unsigned* p)              { return __hip_atomic_load(p, __ATOMIC_RELAXED, __HIP_MEMORY_SCOPE_AGENT); }
__device__ __forceinline__ unsigned xb_add(unsigned* p, unsigned v) { return __hip_atomic_fetch_add(p, v, __ATOMIC_RELAXED, __HIP_MEMORY_SCOPE_AGENT); }
__device__ __forceinline__ unsigned xb_xcc_id() { return (unsigned)__builtin_amdgcn_s_getreg((3 << 11) | 20) & 0xFu; }
#define XB_SPIN(cond, bar) do { unsigned _sp = 0; while (cond) { __builtin_amdgcn_s_sleep(1); \
    if ((++_sp & 255u) == 0u) { if (xb_ld(&(bar)[XB_TMO])) break; if (_sp > XB_SPIN_CAP) { atomicAdd(&(bar)[XB_TMO], 1u); break; } } } } while (0)
struct XcdBarrier { unsigned* bar; unsigned x; volatile LAS unsigned* st; };
__device__ __forceinline__ XcdBarrier xcd_barrier_post(unsigned* bar, volatile LAS unsigned* st) {
    XcdBarrier b; b.bar = bar; b.x = xb_xcc_id(); b.st = st;
    if (threadIdx.x == 0) (void)xb_add(&bar[XB_XCNT(b.x)], 1u);
    return b;
}
__device__ __forceinline__ void xcd_barrier_complete(unsigned* bar, unsigned x, unsigned& nloc, unsigned& nx) {
    const unsigned G = gridDim.x * gridDim.y * gridDim.z;
    unsigned sum, cnt, mine, sp = 0u;
    for (;;) {
        sum = 0u; cnt = 0u; mine = 0u;
#pragma unroll
        for (unsigned j = 0; j < 16; ++j) { const unsigned c = xb_ld(&bar[XB_XCNT(j)]); sum += c; cnt += (c > 0u) ? 1u : 0u; mine = (j == x) ? c : mine; }
        if (sum == G) break;
        __builtin_amdgcn_s_sleep(1);
        if ((++sp & 255u) == 0u) { if (xb_ld(&bar[XB_TMO])) break; if (sp > XB_SPIN_CAP) { atomicAdd(&bar[XB_TMO], 1u); break; } }
    }
    nloc = mine > 0u ? mine : 1u; nx = cnt > 0u ? cnt : 1u;
}
__device__ __forceinline__ void xcd_barrier_protocol(const XcdBarrier& b) {
    unsigned* bar = b.bar;
    __builtin_amdgcn_s_waitcnt(0);
    unsigned nloc = b.st[0], nx = b.st[1];
    if (nloc == 0u) { xcd_barrier_complete(bar, b.x, nloc, nx); b.st[0] = nloc; b.st[1] = nx; }
    const unsigned old = xb_add(&bar[XB_XSUB(b.x)], 1u);
    const unsigned gen = old / nloc;
    if (old + 1u == (gen + 1u) * nloc) {
        __builtin_amdgcn_fence(__ATOMIC_RELEASE, "agent");
        asm volatile("s_waitcnt vmcnt(0)" ::: "memory");
        const unsigned og = xb_add(&bar[XB_TOP], 1u);
        const unsigned tg = og / nx;
        if (og + 1u == (tg + 1u) * nx) xb_add(&bar[XB_TOPGEN], 1u);
        else XB_SPIN(xb_ld(&bar[XB_TOPGEN]) == tg, bar);
        __builtin_amdgcn_fence(__ATOMIC_ACQUIRE, "agent");
        xb_add(&bar[XB_XGEN(b.x)], 1u);
        asm volatile("s_waitcnt vmcnt(0)" ::: "memory");
    } else {
        XB_SPIN(xb_ld(&bar[XB_XGEN(b.x)]) == gen, bar);
        __builtin_amdgcn_fence(__ATOMIC_ACQUIRE, "agent");
        asm volatile("s_waitcnt vmcnt(0)" ::: "memory");
    }
}
__device__ __forceinline__ void xcd_barrier(const XcdBarrier& b) {
    asm volatile("s_waitcnt vmcnt(0)" ::: "memory");
    __syncthreads();
    if (threadIdx.x == 0) xcd_barrier_protocol(b);
    __syncthreads();
}

__device__ __forceinline__ float wave_sum(float v) {
#pragma unroll
    for (int o = 1; o < 64; o <<= 1) v += __shfl_xor(v, o);
    return v;
}

struct TItem { const float* W; bf16* WT; const float* ks; const float* ns; int N, ldt, orow, k0, n0; float kson, nson; };
__device__ __forceinline__ void titem_decode(int it, TItem& d, const float* const* in, bf16* WIN, bf16* WGLU, bf16* WPOOL, bf16* WOUT, bf16* WGU, bf16* WDOWN) {
    constexpr int I_IN = 32 * 64, I_GLU = 16 * 32, I_POOL = 4 * 32, I_OUT = 32 * 64, I_G = 32 * 176;
    int r = it; d.ks = in[1]; d.ns = in[1]; d.kson = 0.f; d.nson = 0.f;
    if (r < I_IN) { const int kb = r / 64, nb = r % 64; d.W = in[2]; d.N = DM; d.WT = WIN; d.ldt = DM; d.orow = 32 * nb; d.k0 = 64 * kb; d.n0 = 32 * nb; d.ks = in[1]; d.kson = 1.f; return; } r -= I_IN;
    if (r < I_GLU) { const int kb = r / 32, nb = r % 32; d.W = in[11]; d.N = SSMW; d.WT = WGLU; d.ldt = SSMW; d.orow = 32 * nb; d.k0 = 64 * kb; d.n0 = 32 * nb; return; } r -= I_GLU;
    if (r < I_POOL) { const int kg = r / 32, q = r % 32, kb = q / 8, nb = q % 8; d.W = in[13] + (size_t)kg * 65536; d.N = 256; d.WT = WPOOL + (size_t)kg * 256 * 1024; d.ldt = 1024; d.orow = 32 * nb; d.k0 = 64 * kb; d.n0 = 32 * nb;
        d.ns = in[15] + kg * 256; d.nson = 1.f; return; } r -= I_POOL;
    if (r < I_OUT) { const int kb = r / 64, nb = r % 64; d.W = in[16]; d.N = DM; d.WT = WOUT; d.ldt = DM; d.orow = 32 * nb; d.k0 = 64 * kb; d.n0 = 32 * nb; return; } r -= I_OUT;
    if (r < I_G) { const int kb = r / 176, nb = r % 176, n0 = 32 * nb; d.W = in[18]; d.N = DFF; d.WT = WGU; d.ldt = DM; d.orow = (n0 >> 7) * 256 + (n0 & 127); d.k0 = 64 * kb; d.n0 = n0; d.ks = in[17]; d.kson = 1.f; return; } r -= I_G;
    if (r < I_G) { const int kb = r / 176, nb = r % 176, n0 = 32 * nb; d.W = in[19]; d.N = DFF; d.WT = WGU; d.ldt = DM; d.orow = (n0 >> 7) * 256 + 128 + (n0 & 127); d.k0 = 64 * kb; d.n0 = n0; d.ks = in[17]; d.kson = 1.f; return; } r -= I_G;
    { const int kb = r / 64, nb = r % 64; d.W = in[20]; d.N = DM; d.WT = WDOWN; d.ldt = DFF; d.orow = 32 * nb; d.k0 = 64 * kb; d.n0 = 32 * nb; }
}
__device__ __forceinline__ void titem_load(const TItem& d, float (&v)[32], int lane) {
#pragma unroll
    for (int i = 0; i < 32; ++i) { const int kk = 2 * i + (lane >> 5); v[i] = __builtin_nontemporal_load(d.W + ((size_t)(d.k0 + kk) * d.N + d.n0 + (lane & 31))); }
}
__device__ __forceinline__ void titem_store(const TItem& d, const float (&v)[32], LAS float* scr, int lane) {
#pragma unroll
    for (int i = 0; i < 32; ++i) { const int kk = 2 * i + (lane >> 5); const float sc = d.ks[(d.k0 + kk) & 2047] * d.kson + (1.0f - d.kson); scr[kk * 33 + (lane & 31)] = v[i] * sc; }
    LDS_WAIT(); asm volatile("" ::: "memory");
    const int c = lane & 7;
#pragma unroll
    for (int j = 0; j < 4; ++j) { const int n = (lane >> 3) + 8 * j; const LAS float* s = scr + (8 * c) * 33 + n; const float sc = d.ns[(d.n0 + n) & 255] * d.nson + (1.0f - d.nson);
        v4u o; o.x = pk2(s[0 * 33] * sc, s[1 * 33] * sc); o.y = pk2(s[2 * 33] * sc, s[3 * 33] * sc); o.z = pk2(s[4 * 33] * sc, s[5 * 33] * sc); o.w = pk2(s[6 * 33] * sc, s[7 * 33] * sc);
        *(v4u*)(d.WT + (size_t)(d.orow + n) * d.ldt + d.k0 + 8 * c) = o; }
    LDS_WAIT(); asm volatile("" ::: "memory");
}
__device__ __forceinline__ void titem_run(int it, const float* const* in, bf16* WIN, bf16* WGLU, bf16* WPOOL, bf16* WOUT, bf16* WGU, bf16* WDOWN, LAS float* scr, int lane) {
    TItem d; float v[32]; titem_decode(it, d, in, WIN, WGLU, WPOOL, WOUT, WGU, WDOWN); titem_load(d, v, lane); titem_store(d, v, scr, lane);
}
__device__ __forceinline__ void x_rows2_to_bf16(const float* x, bf16* XBp, float* rstd, int m0, int m1, int lane) {
    const f32x4* xa = (const f32x4*)(x + (size_t)m0 * DM) + lane; const f32x4* xc = (const f32x4*)(x + (size_t)m1 * DM) + lane; f32x4 va[8], vc[8];
#pragma unroll
    for (int j = 0; j < 8; ++j) va[j] = __builtin_nontemporal_load(xa + 64 * j);
#pragma unroll
    for (int j = 0; j < 8; ++j) vc[j] = __builtin_nontemporal_load(xc + 64 * j);
    float sa = 0.f, sc = 0.f;
#pragma unroll
    for (int j = 0; j < 8; ++j) { sa += (va[j].x * va[j].x + va[j].y * va[j].y) + (va[j].z * va[j].z + va[j].w * va[j].w); sc += (vc[j].x * vc[j].x + vc[j].y * vc[j].y) + (vc[j].z * vc[j].z + vc[j].w * vc[j].w); }
    sa = wave_sum(sa); sc = wave_sum(sc);
    if (lane == 0) { rstd[m0] = 1.0f / sqrtf(sa * (1.0f / DM) + 1e-6f); rstd[m1] = 1.0f / sqrtf(sc * (1.0f / DM) + 1e-6f); }
    v2u* oa = (v2u*)(XBp + (size_t)m0 * DM) + lane; v2u* oc = (v2u*)(XBp + (size_t)m1 * DM) + lane;
#pragma unroll
    for (int j = 0; j < 8; ++j) { v2u w; w.x = pk2(va[j].x, va[j].y); w.y = pk2(va[j].z, va[j].w); oa[64 * j] = w; }
#pragma unroll
    for (int j = 0; j < 8; ++j) { v2u w; w.x = pk2(vc[j].x, vc[j].y); w.y = pk2(vc[j].z, vc[j].w); oc[64 * j] = w; }
}
__device__ __forceinline__ void s5_tables_group(int g, LAS unsigned char* lds, int tid, const float* lre, const float* lim, const float* lstep, const float* bre, const float* bim,
                                                const float* cre, const float* cim, const float* dsk, bf16* BtA, bf16* BtB, float* LT) {
    LAS float* Lp = (LAS float*)lds;
    LAS float* Bb = Lp + 17 * 64 * 2;
    LAS float* Cc = Bb + 2048;
    LAS float* Kt = Cc + 2048;
    if (tid < 64) { const int p = tid;
        const double step = exp((double)lstep[g]), lr = lre[g * 64 + p], li = lim[g * 64 + p];
        const double er = exp(lr * step), Lr = er * cos(li * step), Li = er * sin(li * step);
        double pr = 1.0, pi = 0.0;
        for (int tau = 0; tau <= 16; ++tau) { Lp[(tau * 64 + p) * 2] = (float)pr; Lp[(tau * 64 + p) * 2 + 1] = (float)pi; const double nr = pr * Lr - pi * Li, ni = pr * Li + pi * Lr; pr = nr; pi = ni; }
        LT[(g * 64 + p) * 2] = Lp[(16 * 64 + p) * 2]; LT[(g * 64 + p) * 2 + 1] = Lp[(16 * 64 + p) * 2 + 1];
        const double nr = Lr - 1.0, ni = Li, den = lr * lr + li * li, qr = (nr * lr + ni * li) / den, qi = (ni * lr - nr * li) / den;
        for (int h = 0; h < 16; ++h) { const double br = bre[(g * 64 + p) * 16 + h], bi = bim[(g * 64 + p) * 16 + h];
            Bb[(p * 16 + h) * 2] = (float)(qr * br - qi * bi); Bb[(p * 16 + h) * 2 + 1] = (float)(qr * bi + qi * br); } }
    for (int idx = tid; idx < 1024; idx += 512) { Cc[idx * 2] = cre[g * 1024 + idx]; Cc[idx * 2 + 1] = cim[g * 1024 + idx]; }
    __syncthreads();
    for (int e = tid; e < 4096; e += 512) { const int tau = e >> 8, hp = (e >> 4) & 15, h = e & 15; float sum = 0.f;
        for (int p = 0; p < 64; ++p) { const float cr = Cc[(hp * 64 + p) * 2], ci = Cc[(hp * 64 + p) * 2 + 1], lr = Lp[(tau * 64 + p) * 2], li = Lp[(tau * 64 + p) * 2 + 1];
            const float er = cr * lr - ci * li, ei = cr * li + ci * lr; sum += er * Bb[(p * 16 + h) * 2] - ei * Bb[(p * 16 + h) * 2 + 1]; }
        if (tau == 0 && hp == h) sum += dsk[g * 16 + h];
        Kt[e] = sum; }
    __syncthreads();
    for (int e = tid; e < 256 * 192; e += 512) { const int row = e / 192, col = 2 * (e % 192), i = row >> 4, hp = row & 15; float v0, v1;
        if (col < 256) { const int j = col >> 4, h = col & 15; v0 = j <= i ? Kt[((i - j) * 16 + hp) * 16 + h] : 0.f; v1 = j <= i ? Kt[((i - j) * 16 + hp) * 16 + h + 1] : 0.f; }
        else { const int im = col >= 320, p = (col - 256) & 63; float e0, e1;
            { const float cr = Cc[(hp * 64 + p) * 2], ci = Cc[(hp * 64 + p) * 2 + 1], lr = Lp[((i + 1) * 64 + p) * 2], li = Lp[((i + 1) * 64 + p) * 2 + 1]; e0 = im ? -(cr * li + ci * lr) : (cr * lr - ci * li); }
            { const float cr = Cc[(hp * 64 + p + 1) * 2], ci = Cc[(hp * 64 + p + 1) * 2 + 1], lr = Lp[((i + 1) * 64 + p + 1) * 2], li = Lp[((i + 1) * 64 + p + 1) * 2 + 1]; e1 = im ? -(cr * li + ci * lr) : (cr * lr - ci * li); }
            v0 = e0; v1 = e1; }
        *(unsigned*)(BtB + ((size_t)(g * 256 + row)) * AGK + col) = pk2(v0, v1); }
    for (int e = tid; e < 128 * 128; e += 512) { const int q = e >> 7, col = 2 * (e & 127), p = q & 63, im = q >> 6, j = col >> 4, h = col & 15;
        const float lr = Lp[((15 - j) * 64 + p) * 2], li = Lp[((15 - j) * 64 + p) * 2 + 1];
        const float b0r = Bb[(p * 16 + h) * 2], b0i = Bb[(p * 16 + h) * 2 + 1], b1r = Bb[(p * 16 + h + 1) * 2], b1i = Bb[(p * 16 + h + 1) * 2 + 1];
        const float v0 = im ? (lr * b0i + li * b0r) : (lr * b0r - li * b0i), v1 = im ? (lr * b1i + li * b1r) : (lr * b1r - li * b1i);
        *(unsigned*)(BtA + ((size_t)(g * 128 + q)) * 256 + col) = pk2(v0, v1); }
    __syncthreads();
}
__device__ __forceinline__ void s5_scan_item(int w, LAS unsigned char* lds, int tid, const float* SLOC, const float* LT, bf16* AG) {
    const int g = w >> 2, p = (w & 3) * 16 + (tid & 15), seg = tid >> 4, pl = tid & 15;
    const float Lr = LT[(g * 64 + p) * 2], Li = LT[(g * 64 + p) * 2 + 1];
    const float* base = SLOC + ((size_t)(g * NCHK + seg * 32)) * 128 + p;
    float ar[32], ai[32];
#pragma unroll
    for (int k = 0; k < 32; ++k) { ar[k] = base[(size_t)k * 128]; ai[k] = base[(size_t)k * 128 + 64]; }
    float sr = 0.f, si = 0.f;
#pragma unroll
    for (int k = 0; k < 32; ++k) { const float tr = ar[k], ti = ai[k]; ar[k] = sr; ai[k] = si; const float nr = Lr * sr - Li * si + tr, ni = Lr * si + Li * sr + ti; sr = nr; si = ni; }
    LAS float* End = (LAS float*)lds;
    End[(seg * 16 + pl) * 2] = sr; End[(seg * 16 + pl) * 2 + 1] = si;
    __syncthreads();
    float Mr = Lr, Mi = Li;
#pragma unroll
    for (int q = 0; q < 5; ++q) { const float nr = Mr * Mr - Mi * Mi, ni = 2.f * Mr * Mi; Mr = nr; Mi = ni; }
    float cr = 0.f, ci = 0.f;
    for (int s2 = 0; s2 < seg; ++s2) { const float er = End[(s2 * 16 + pl) * 2], ei = End[(s2 * 16 + pl) * 2 + 1]; const float nr = Mr * cr - Mi * ci + er, ni = Mr * ci + Mi * cr + ei; cr = nr; ci = ni; }
    bf16* dst = AG + ((size_t)(g * NCHK + seg * 32)) * AGK + 256 + p;
#pragma unroll
    for (int k = 0; k < 32; ++k) { dst[(size_t)k * AGK] = (bf16)f2bf(ar[k] + cr); dst[(size_t)k * AGK + 64] = (bf16)f2bf(ai[k] + ci); const float nr = Lr * cr - Li * ci, ni = Lr * ci + Li * cr; cr = nr; ci = ni; }
    __syncthreads();
}
template <int KG> __device__ __forceinline__ void pool_half_t(int tb, int oct, const bf16* V, bf16* PO) {
    constexpr int W = 2 << KG, NR = 7 + W;
    const bf16* vp = V + oct * 8; bf16* op = PO + oct * 8;
    v4u q[NR];
#pragma unroll
    for (int j = 0; j < NR; ++j) { const int sr = tb - (W - 1) + j; q[j] = (v4u){0u, 0u, 0u, 0u}; if (sr >= 0) q[j] = *(const v4u*)(vp + (size_t)sr * 1024); }
    float sum[8];
#pragma unroll
    for (int j = 0; j < 8; ++j) sum[j] = 0.f;
#pragma unroll
    for (int j = 0; j < W - 1; ++j) { const v4u r = q[j];
        sum[0] += pg8::bf_lo(r.x); sum[1] += pg8::bf_hi(r.x); sum[2] += pg8::bf_lo(r.y); sum[3] += pg8::bf_hi(r.y); sum[4] += pg8::bf_lo(r.z); sum[5] += pg8::bf_hi(r.z); sum[6] += pg8::bf_lo(r.w); sum[7] += pg8::bf_hi(r.w); }
#pragma unroll
    for (int i = 0; i < 8; ++i) { const int t = tb + i; const v4u c = q[W - 1 + i];
        const float cur[8] = {pg8::bf_lo(c.x), pg8::bf_hi(c.x), pg8::bf_lo(c.y), pg8::bf_hi(c.y), pg8::bf_lo(c.z), pg8::bf_hi(c.z), pg8::bf_lo(c.w), pg8::bf_hi(c.w)};
        const float inv = 1.0f / (float)(t + 1 < W ? t + 1 : W); float o[8];
#pragma unroll
        for (int j = 0; j < 8; ++j) { sum[j] += cur[j]; o[j] = sum[j] * inv - cur[j]; }
        v4u ow; ow.x = pk2(o[0], o[1]); ow.y = pk2(o[2], o[3]); ow.z = pk2(o[4], o[5]); ow.w = pk2(o[6], o[7]);
        *(v4u*)(op + (size_t)t * 1024) = ow;
        const v4u r = q[i];
        sum[0] -= pg8::bf_lo(r.x); sum[1] -= pg8::bf_hi(r.x); sum[2] -= pg8::bf_lo(r.y); sum[3] -= pg8::bf_hi(r.y); sum[4] -= pg8::bf_lo(r.z); sum[5] -= pg8::bf_hi(r.z); sum[6] -= pg8::bf_lo(r.w); sum[7] -= pg8::bf_hi(r.w); }
}
__device__ __forceinline__ void pool_half(int kg, int tb, int oct, const bf16* V, bf16* PO) {
    if (kg == 0) pool_half_t<0>(tb, oct, V, PO); else if (kg == 1) pool_half_t<1>(tb, oct, V, PO); else if (kg == 2) pool_half_t<2>(tb, oct, V, PO); else pool_half_t<3>(tb, oct, V, PO);
}
__device__ __forceinline__ void pool_run(int kg, int t0, int oct, const bf16* V, bf16* PO) {
#pragma unroll 1
    for (int hh = 0; hh < 2; ++hh) pool_half(kg, t0 + 8 * hh, oct, V, PO);
}
__device__ __forceinline__ void pool_tile_workers(int bx, int wave, int lane, const bf16* V, bf16* PO) {
    const int kg = bx >> 6, pm = bx & 63;
#pragma unroll 1
    for (int h = (wave - 1) * 64 + lane; h < 1024; h += 448) pool_half(kg, 256 * pm + 8 * (h >> 5), kg * 32 + (h & 31), V, PO);
}

__device__ __forceinline__ void pool_item(int idx, const bf16* V, bf16* PO) { const int kg = (idx >> 6) & 3; pool_run(kg, (2 * (idx >> 8) + ((idx >> 5) & 1)) * 16, kg * 32 + (idx & 31), V, PO); }
__device__ __forceinline__ void s5_scan_merged(int u, LAS unsigned char* lds, int wave, int lane, const float* SLOC, const float* LT, bf16* AG, unsigned long long* XE, unsigned* XF, unsigned* tmo,
                                               const bf16* V, bf16* PO) {
    const int g = u >> 2, pmm = u & 3, p = lane, sg = wave, c0 = pmm * 256;
    const float Lr = LT[(g * 64 + p) * 2], Li = LT[(g * 64 + p) * 2 + 1];
    const float* base = SLOC + ((size_t)(g * NCHK + c0 + sg * 32)) * 128 + p;
    float ar[32], ai[32];
#pragma unroll
    for (int k = 0; k < 32; ++k) { ar[k] = base[(size_t)k * 128]; ai[k] = base[(size_t)k * 128 + 64]; }
    float sr = 0.f, si = 0.f;
#pragma unroll
    for (int k = 0; k < 32; ++k) { const float tr = ar[k], ti = ai[k]; ar[k] = sr; ai[k] = si; const float nr = Lr * sr - Li * si + tr, ni = Lr * si + Li * sr + ti; sr = nr; si = ni; }
    LAS float* End = (LAS float*)lds;
    End[(sg * 64 + p) * 2] = sr; End[(sg * 64 + p) * 2 + 1] = si;
    __syncthreads();
    float Mr = Lr, Mi = Li;
#pragma unroll
    for (int q = 0; q < 5; ++q) { const float nr = Mr * Mr - Mi * Mi, ni = 2.f * Mr * Mi; Mr = nr; Mi = ni; }
    float cr = 0.f, ci = 0.f;
    for (int s2 = 0; s2 < sg; ++s2) { const float er = End[(s2 * 64 + p) * 2], ei = End[(s2 * 64 + p) * 2 + 1]; const float nr = Mr * cr - Mi * ci + er, ni = Mr * ci + Mi * cr + ei; cr = nr; ci = ni; }
    if (sg == 7) {
        const float er = Mr * cr - Mi * ci + sr, ei = Mr * ci + Mi * cr + si;
        __hip_atomic_store(XE + (size_t)u * 128 + p, (1ull << 32) | __float_as_uint(er), __ATOMIC_RELAXED, __HIP_MEMORY_SCOPE_AGENT);
        __hip_atomic_store(XE + (size_t)u * 128 + 64 + p, (1ull << 32) | __float_as_uint(ei), __ATOMIC_RELAXED, __HIP_MEMORY_SCOPE_AGENT);
    }
    float M8r = Mr, M8i = Mi;
#pragma unroll
    for (int q = 0; q < 3; ++q) { const float nr = M8r * M8r - M8i * M8i, ni = 2.f * M8r * M8i; M8r = nr; M8i = ni; }
    float Cr = 0.f, Ci = 0.f;
    if (pmm > 0) {
        unsigned long long er_[3], ei_[3]; unsigned sp = 0;
        for (;;) { bool ok = true;
#pragma unroll
            for (int j = 0; j < 3; ++j) { er_[j] = 1ull << 32; ei_[j] = 1ull << 32;
                if (j < pmm) { const unsigned long long* q = XE + (size_t)(g * 4 + j) * 128 + p; er_[j] = __hip_atomic_load(q, __ATOMIC_RELAXED, __HIP_MEMORY_SCOPE_AGENT); ei_[j] = __hip_atomic_load(q + 64, __ATOMIC_RELAXED, __HIP_MEMORY_SCOPE_AGENT); }
                ok = ok && ((unsigned)(er_[j] >> 32) == 1u) && ((unsigned)(ei_[j] >> 32) == 1u); }
            if (__all(ok ? 1 : 0)) break;
            __builtin_amdgcn_s_sleep(2); if (++sp > (1u << 20)) { if (lane == 0) __hip_atomic_store(tmo, 1u, __ATOMIC_RELAXED, __HIP_MEMORY_SCOPE_AGENT); break; } }
#pragma unroll
        for (int j = 0; j < 3; ++j) if (j < pmm) { const float er = __uint_as_float((unsigned)er_[j]), ei = __uint_as_float((unsigned)ei_[j]);
            const float nr = M8r * Cr - M8i * Ci + er, ni = M8r * Ci + M8i * Cr + ei; Cr = nr; Ci = ni; }
    }
    for (int q = 0; q < sg; ++q) { const float nr = Mr * Cr - Mi * Ci, ni = Mr * Ci + Mi * Cr; Cr = nr; Ci = ni; }
    cr += Cr; ci += Ci;
    bf16* dst = AG + ((size_t)(g * NCHK + c0 + sg * 32)) * AGK + 256 + p;
#pragma unroll
    for (int k = 0; k < 32; ++k) { dst[(size_t)k * AGK] = (bf16)f2bf(ar[k] + cr); dst[(size_t)k * AGK + 64] = (bf16)f2bf(ai[k] + ci); const float nr = Lr * cr - Li * ci, ni = Lr * ci + Li * cr; cr = nr; ci = ni; }
    asm volatile("s_waitcnt vmcnt(0)" ::: "memory");
    __syncthreads();
}

struct Args { const float* in[22]; float* out; unsigned char* ws; int ph_lo, ph_hi, li, pad; };
__global__ void __launch_bounds__(NWAVES * 64, 2) mk_fwd(Args args) {
    extern __shared__ __attribute__((aligned(16))) unsigned char lds_raw[];
    LAS unsigned char* lds = (LAS unsigned char*)lds_raw;
    volatile LAS unsigned* MISC = (volatile LAS unsigned*)(lds + MISC_OFF);
    const int tid = threadIdx.x, lane = tid & 63, wave = __builtin_amdgcn_readfirstlane(tid >> 6);
    const int G = gridDim.x, bx = blockIdx.x;
    unsigned char* ws = args.ws;
    unsigned* ctl = (unsigned*)(ws + WS_CTL);
    const float* x = args.in[0]; float* out = args.out;
    bf16* WIN = (bf16*)(ws + WS_WIN); bf16* WGLU = (bf16*)(ws + WS_WGLU); bf16* WPOOL = (bf16*)(ws + WS_WPOOL); bf16* WOUT = (bf16*)(ws + WS_WOUT);
    bf16* WGU = (bf16*)(ws + WS_WGU); bf16* WDOWN = (bf16*)(ws + WS_WDOWN); bf16* BTA = (bf16*)(ws + WS_BTA); bf16* BTB = (bf16*)(ws + WS_BTB);
    bf16* XB = (bf16*)(ws + WS_XB); bf16* AG = (bf16*)(ws + WS_AG); bf16* VB = (bf16*)(ws + WS_V); float* SLOC = (float*)(ws + WS_SLOC);
    bf16* GBUF = (bf16*)(ws + WS_GBUF); bf16* POOLED = (bf16*)(ws + WS_POOLED); bf16* FFB = (bf16*)(ws + WS_FF); bf16* MIXED = (bf16*)(ws + WS_MIXED);
    float* BIASP = (float*)(ws + WS_BIASP); float* LT = (float*)(ws + WS_LT); float* RSTD1 = (float*)(ws + WS_RSTD1);
    float* ROWSS2 = (float*)(ws + WS_CTL + CTL_ROWSS2); float* ROWSS3 = (float*)(ws + WS_CTL + CTL_ROWSS3);

    for (int u = tid; u < (LDS_BYTES - LDSCTL_OFF) / 4; u += NWAVES * 64) ((LAS unsigned*)(lds + LDSCTL_OFF))[u] = 0u;
    __syncthreads();
    XcdBarrier bar; bar.bar = ctl + CW_BAR; bar.x = 0; bar.st = nullptr;
    if (!MK_PER_PHASE) bar = xcd_barrier_post(ctl + CW_BAR, MISC + 8);
    constexpr int NITEMS = 32 * 64 + 16 * 32 + 4 * 32 + 32 * 64 + 2 * 32 * 176 + 88 * 64, IT_WIN = 2048, IT_POOLGLU = 2688, IT_WOUT = 4736, IT_WGU = 16000;
    const bool defer = !MK_PER_PHASE && G == 256;
    const int NWORK = G * (NWAVES - 1);
    int dnext = IT_WIN + bx * (NWAVES - 1) + (wave - 1);
    unsigned bar_seq = 0;
#define DEFER_LIMIT(seam) ((seam) < 1 ? IT_WIN : (seam) < 5 ? IT_POOLGLU : (seam) == 5 ? IT_WOUT : (seam) == 6 ? IT_WGU : NITEMS)
#define GRID_BAR(seam) do { if (MK_PER_PHASE) { if (tid == 0) __hip_atomic_store(ctl + CW_TMO, 0xBADBA0u | (unsigned)(seam), __ATOMIC_RELAXED, __HIP_MEMORY_SCOPE_AGENT); } else { \
        LAS float* scr_ = (LAS float*)(lds + RING_OFF + wave * 16384); \
        if (defer && wave != 0) { const int lim_ = DEFER_LIMIT(seam); while (dnext < lim_) { titem_run(dnext, args.in, WIN, WGLU, WPOOL, WOUT, WGU, WDOWN, scr_, lane); dnext += NWORK; } } \
        asm volatile("s_waitcnt vmcnt(0)" ::: "memory"); __syncthreads(); ++bar_seq; \
        if (wave == 0) { if (threadIdx.x == 0) { xcd_barrier_protocol(bar); MISC[12] = bar_seq; } } \
        else if (defer) { if ((seam) == 4) pool_tile_workers(bx, wave, lane, VB, POOLED);     \
            while (MISC[12] != bar_seq) { if (dnext < NITEMS) { titem_run(dnext, args.in, WIN, WGLU, WPOOL, WOUT, WGU, WDOWN, scr_, lane); dnext += NWORK; } else __builtin_amdgcn_s_sleep(8); } } \
        asm volatile("s_waitcnt vmcnt(0)" ::: "memory"); __syncthreads(); } } while (0)
    const int cu = defer ? ((bx & 7) * 32 + (bx >> 3)) : bx;
    const int lo = args.ph_lo, hi = args.ph_hi;
#define IN(k) (lo <= (k) && (k) < hi)
#define BOTH(k) (IN(k) && IN((k) + 1))
#define REPS(k) (((MK_PROBE_MASK >> (k)) & 1) ? 2 : 1)
    float* const DUMMY_OUT = (float*)(ws + 342 * MiB); float* const DUMMY_SS = (float*)(ws + 470 * MiB); bf16* const DUMMY_HB = (bf16*)(ws + 406 * MiB);

    if (IN(0)) for (int rep = REPS(0); rep > 0; --rep) {
        LAS float* scr = (LAS float*)(lds + RING_OFF + wave * 16384);
        const int gw = bx * NWAVES + wave, NGW = G * NWAVES;
        if (defer) {
            if ((bx & 3) == 3) s5_tables_group(bx >> 2, lds, tid, args.in[3], args.in[4], args.in[5], args.in[6], args.in[7], args.in[8], args.in[9], args.in[10], BTA, BTB, LT);
            else { const int nw = (bx - (bx >> 2)) * NWAVES + wave, NNW = (G - NGRP) * NWAVES;
                for (int m = nw; m < SEQ / 2; m += NNW) x_rows2_to_bf16(x, XB, RSTD1, 2 * m, 2 * m + 1, lane);
                for (int it = nw; it < IT_WIN; it += NNW) titem_run(it, args.in, WIN, WGLU, WPOOL, WOUT, WGU, WDOWN, scr, lane); }
        } else {
            for (int g = bx; g < NGRP; g += G) s5_tables_group(g, lds, tid, args.in[3], args.in[4], args.in[5], args.in[6], args.in[7], args.in[8], args.in[9], args.in[10], BTA, BTB, LT);
            for (int m = gw; m < SEQ / 2; m += NGW) x_rows2_to_bf16(x, XB, RSTD1, 2 * m, 2 * m + 1, lane);
            for (int it = gw; it < NITEMS; it += NGW) titem_run(it, args.in, WIN, WGLU, WPOOL, WOUT, WGU, WDOWN, scr, lane);
        }
        if (bx == 0) for (int i = tid; i < 1024; i += NWAVES * 64) BIASP[i] = args.in[14][i] * args.in[15][i];
        for (int i = bx * (NWAVES * 64) + tid; i < 256 * 128; i += G * NWAVES * 64) ((unsigned long long*)(ws + WS_XE))[i] = 0ull;
        if (BOTH(0) || rep > 1) GRID_BAR(0);
    }
    if (IN(1)) for (int rep = REPS(1); rep > 0; --rep) {
        pg8::Gemm g{XB, WIN, DM, DM, DM, 128}; pg8::StaticOrder S; S.init(SEQ, DM, G, bx, DM, DM, WGM_P1);
        pg8::EpiProj E{AG, VB, RSTD1};
        pg8::gemm_phase<pg8::EpiProj, pg8::StaticOrder, PG8_ALIGN, PG8_SP2>(lds + RING_OFF, g, S, E);
        if (BOTH(1) || rep > 1) GRID_BAR(1);
    }
    if (IN(2)) for (int rep = REPS(2); rep > 0; --rep) {
        pg8::Gemm g{AG, BTA, AGK, 256, 256, 0}; pg8::GroupOrder S{NGRP * 4, G, cu, AGK, 4, (long long)128 * 256};
        pg8::EpiSloc E{SLOC};
        pg8::gemm_phase<pg8::EpiSloc, pg8::GroupOrder, PG8_ALIGN, PG8_SP2>(lds + RING_OFF, g, S, E);
        if (!defer && (BOTH(2) || rep > 1)) GRID_BAR(2);
    }
    if (IN(3)) for (int rep = REPS(3); rep > 0; --rep) {
        if (defer) s5_scan_merged(cu, lds, wave, lane, SLOC, LT, AG, (unsigned long long*)(ws + WS_XE), ctl + CW_XF, ctl + CW_TMO, VB, POOLED);
        else { for (int w = bx; w < 256; w += G) s5_scan_item(w, lds, tid, SLOC, LT, AG);
               for (int idx = bx * (NWAVES * 64) + tid; idx < 131072; idx += G * NWAVES * 64) pool_item(idx, VB, POOLED); }
        if (!defer && (BOTH(3) || rep > 1)) GRID_BAR(3);
    }
    if (IN(4)) for (int rep = REPS(4); rep > 0; --rep) {
        { pg8::Gemm g{AG, BTB, AGK, AGK, AGK, 128}; pg8::GroupOrder S{NGRP * 4, G, cu, AGK, 4, (long long)256 * AGK};
          pg8::EpiS5Out E{GBUF};
          pg8::gemm_phase<pg8::EpiS5Out, pg8::GroupOrder, PG8_ALIGN, PG8_SP2>(lds + RING_OFF, g, S, E); }
        if (!defer) { pg8::Gemm g{POOLED, WPOOL, 1024, 1024, 256, 128}; pg8::PoolOrder S{256, G, bx};
          pg8::EpiPoolOut E{MIXED, BIASP};
          pg8::gemm_phase<pg8::EpiPoolOut, pg8::PoolOrder, PG8_ALIGN, PG8_SP2>(lds + RING_OFF, g, S, E); }
        if (BOTH(4) || rep > 1) GRID_BAR(4);
    }
    if (IN(5)) for (int rep = REPS(5); rep > 0; --rep) {
        pg8::Gemm g{GBUF, WGLU, SSMW, SSMW, SSMW, 128}; pg8::StaticOrder S; S.init(SEQ, SSMW, G, bx, SSMW, SSMW, WGM_P5);
        pg8::EpiGlu E{MIXED, GBUF, args.in[12]};
        if (defer) { pg8::GluPoolOrder S2{S, bx, (long long)(POOLED - GBUF), (long long)(WPOOL - WGLU)}; pg8::EpiGluPool E2{E, pg8::EpiPoolOut{MIXED, BIASP}};
            pg8::gemm_phase<pg8::EpiGluPool, pg8::GluPoolOrder, PG8_ALIGN, PG8_SP2>(lds + RING_OFF, g, S2, E2); }
        else pg8::gemm_phase<pg8::EpiGlu, pg8::StaticOrder, PG8_ALIGN, PG8_SP2>(lds + RING_OFF, g, S, E);
        if (BOTH(5) || rep > 1) GRID_BAR(5);
    }
    if (IN(6)) for (int rep = REPS(6); rep > 0; --rep) {
        pg8::Gemm g{MIXED, WOUT, DM, DM, DM, 128}; pg8::StaticOrder S; S.init(SEQ, DM, G, bx, DM, DM, WGM_P6);
        pg8::EpiResidA E{XB, rep > 1 ? DUMMY_SS : ROWSS2};
        pg8::gemm_phase<pg8::EpiResidA, pg8::StaticOrder, PG8_ALIGN, PG8_SP2>(lds + RING_OFF, g, S, E);
        if (BOTH(6) || rep > 1) GRID_BAR(6);
    }
    if (IN(7)) for (int rep = REPS(7); rep > 0; --rep) {
        pg8::Gemm g{XB, WGU, DM, DM, DM, 128}; pg8::StaticOrder S; S.init(SEQ, 2 * DFF, G, bx, DM, DM, WGM_P7);
        pg8::EpiSwiglu E{FFB, ROWSS2};
        pg8::gemm_phase<pg8::EpiSwiglu, pg8::StaticOrder, PG8_ALIGN, PG8_SP2>(lds + RING_OFF, g, S, E);
        if (BOTH(7) || rep > 1) GRID_BAR(7);
    }
    if (IN(8)) {
        const bool bad = !MK_PER_PHASE && ((__hip_atomic_load(ctl + CW_BAR + XB_TMO, __ATOMIC_RELAXED, __HIP_MEMORY_SCOPE_AGENT) | __hip_atomic_load(ctl + CW_TMO, __ATOMIC_RELAXED, __HIP_MEMORY_SCOPE_AGENT)) != 0u);
        static_assert(PG8_ALIGN, "EpiFinal waits for all 64 waves of its row panel inside the epilogue: both half-workgroups must run their epilogues together (ALIGN_EPI), else the trailing half can never arrive");
        pg8::Gemm g{FFB, WDOWN, DFF, DFF, DFF, 128}; pg8::PanelOrder S{bx, DFF, DFF};
        pg8::EpiFinal E{XB, out, ROWSS3, ctl + CW_PANEL, ctl + CW_TMO, args.in[21]};
        if (G == 256 && !bad) pg8::gemm_phase<pg8::EpiFinal, pg8::PanelOrder, PG8_ALIGN, PG8_SP2>(lds + RING_OFF, g, S, E);
        else { const float qn = __builtin_nanf(""); for (size_t i = (size_t)bx * (NWAVES * 64) + tid; i < (size_t)SEQ * DM / 4; i += (size_t)G * NWAVES * 64) ((f32x4*)out)[i] = (f32x4){qn, qn, qn, qn}; }
    }
#undef IN
#undef BOTH
}

extern "C" void kernel_launch(void* const* d_in, const int* in_sizes, int n_in, void* d_out, int out_size, void* d_ws, size_t ws_size, hipStream_t stream) {
    static int grid = 0;
    if (grid == 0) {
        if (n_in != 22 || in_sizes[0] != SEQ * DM || out_size != SEQ * DM || ws_size < (MK_PROBE_MASK ? 471 * MiB : WS_END)) { fprintf(stderr, "kernel_launch: unexpected problem (n_in %d, in0 %d, out %d, ws %zu); nothing launched\n", n_in, n_in > 0 ? in_sizes[0] : -1, out_size, ws_size); grid = -1; return; }
        int dev = 0, cus = 0, per_cu = 0;
        if (hipGetDevice(&dev) != hipSuccess || hipDeviceGetAttribute(&cus, hipDeviceAttributeMultiprocessorCount, dev) != hipSuccess) { grid = -1; return; }
        if (hipFuncSetAttribute((const void*)mk_fwd, hipFuncAttributeMaxDynamicSharedMemorySize, LDS_BYTES) != hipSuccess) { fprintf(stderr, "kernel_launch: hipFuncSetAttribute failed\n"); grid = -1; return; }
        if (hipOccupancyMaxActiveBlocksPerMultiprocessor(&per_cu, (const void*)mk_fwd, NWAVES * 64, LDS_BYTES) != hipSuccess || per_cu < 1) { fprintf(stderr, "kernel_launch: occupancy query says %d blocks per CU\n", per_cu); }
        (void)hipGetLastError();
        grid = cus < 256 ? cus : 256;
    }
    if (grid < 0) return;
    (void)hipMemsetAsync((char*)d_ws + WS_CTL, 0, CTL_ZERO_BYTES, stream);
    Args a{};
    for (int i = 0; i < 22; ++i) a.in[i] = (const float*)d_in[i];
    a.out = (float*)d_out; a.ws = (unsigned char*)d_ws;
#if MK_PER_PHASE
    for (int p = 0; p < N_PHASES; ++p) { a.ph_lo = p; a.ph_hi = p + 1; a.li = p; hipLaunchKernelGGL(mk_fwd, dim3(grid), dim3(NWAVES * 64), LDS_BYTES, stream, a); }
#else
    a.ph_lo = 0; a.ph_hi = N_PHASES; a.li = 0;
    hipLaunchKernelGGL(mk_fwd, dim3(grid), dim3(NWAVES * 64), LDS_BYTES, stream, a);
#endif
}
```

```cpp
#include <hip/hip_runtime.h>
#include <cstdio>
#include <cstdint>

#ifndef MK_PROBE_MASK
#define MK_PROBE_MASK 0
#endif
#ifndef MK_PER_PHASE
#define MK_PER_PHASE 0
#endif

namespace pg8 {
#define PG8_LAS __attribute__((address_space(3)))
typedef unsigned short bf16_t;
typedef short bf16x8 __attribute__((ext_vector_type(8)));
typedef float f32x4 __attribute__((ext_vector_type(4)));
typedef float f32x2 __attribute__((ext_vector_type(2)));
typedef unsigned u32x4 __attribute__((ext_vector_type(4)));
constexpr int BM = 256, BK = 64, HALF = 128, HTB = HALF * BK * 2, STAGE_BYTES = 8 * HTB, NXCD = 8, WGM = 8;

__host__ __device__ __forceinline__ int lds_byte(int r, int c) { const int st = (r >> 4) * 2 + (c >> 5), rr = r & 15, cc = c & 31, ob = rr * 64 + cc * 2; return st * 1024 + (ob ^ (((ob >> 9) & 1) << 5)); }
__host__ __device__ __forceinline__ void stage_rc(int b, int& R, int& C) { const int st = b / 1024, sb = b % 1024, swz = sb ^ (((sb >> 9) & 1) << 5); R = (st >> 1) * 16 + swz / 64; C = (st & 1) * 32 + (swz % 64) / 2; }
__host__ __device__ __forceinline__ int perm32(int rho) { const int n = rho >> 4, i = rho & 15; return 8 * (i >> 2) + 4 * n + (i & 3); }

struct Unit { int pm, pn, ntk, kind; long long aoff, boff; };
struct Gemm { const bf16_t* A; const bf16_t* Bt; int lda, ldb, K, hsB; };

struct StaticOrder {
    int nM, nN, nwg, G, c, lda, ldb, wgm;
    __device__ void init(int M, int N, int G_, int c_, int lda_, int ldb_, int wgm_ = WGM) { nM = M / BM; nN = N / BM; nwg = nM * nN; G = G_; c = c_; lda = lda_; ldb = ldb_; wgm = wgm_; }
    __device__ bool next(int i, Unit& u) const {
        const long L = (long)i * G + c; if (L >= nwg) return false;
        int wgid = (int)L; { const int q = nwg / NXCD, r = nwg % NXCD, xcd = wgid % NXCD, off = wgid / NXCD; wgid = (xcd < r ? xcd * (q + 1) : r * (q + 1) + (xcd - r) * q) + off; }
        const int nig = wgm * nN, gid = wgid / nig, fm = gid * wgm, gsz = (nM - fm) < wgm ? (nM - fm) : wgm;
        u.pm = fm + ((wgid % nig) % gsz); u.pn = (wgid % nig) / gsz; u.ntk = 0; u.kind = 0;
        u.aoff = (long long)u.pm * BM * lda; u.boff = (long long)u.pn * BM * ldb; return true;
    }
    __device__ __forceinline__ void a_ready(const Unit&) const {}
    __device__ __forceinline__ void done(const Unit&) const {}
};
struct GroupOrder {
    int n, G, c, lda, per; long long bstride;
    __device__ bool next(int i, Unit& u) const { const int idx = i * G + c; if (idx >= n) return false; u.pm = idx; u.pn = 0; u.ntk = 0; u.kind = 0; u.aoff = (long long)idx * BM * lda; u.boff = (long long)(idx / per) * bstride; return true; }
    __device__ __forceinline__ void a_ready(const Unit&) const {}
    __device__ __forceinline__ void done(const Unit&) const {}
};
struct PoolOrder {
    int n, G, c;
    __device__ bool next(int i, Unit& u) const { const int idx = i * G + c; if (idx >= n) return false; u.pm = idx & 63; u.pn = idx >> 6; u.ntk = 0; u.kind = 0; u.aoff = (long long)u.pm * BM * 1024 + u.pn * 256; u.boff = (long long)u.pn * 256 * 1024; return true; }
    __device__ __forceinline__ void a_ready(const Unit&) const {}
    __device__ __forceinline__ void done(const Unit&) const {}
};

struct GluPoolOrder {
    StaticOrder so; int c; long long a1, b1;
    __device__ bool next(int i, Unit& u) const { if (i == 0) return so.next(0, u); if (i > 1) return false;
        u.pm = (c & 7) * 8 + ((c >> 3) & 7); u.pn = c >> 6; u.ntk = 4;     u.kind = 1; u.aoff = a1 + (long long)u.pm * BM * 1024 + u.pn * 256; u.boff = b1 + (long long)u.pn * 256 * 1024; return true; }
    __device__ __forceinline__ void a_ready(const Unit&) const {}
    __device__ __forceinline__ void done(const Unit&) const {}
};
struct PanelOrder {
    int c, lda, ldb;
    __device__ bool next(int i, Unit& u) const { if (i >= 2) return false; const int xcd = c & 7, local = c >> 3; u.pm = xcd * 8 + i * 4 + (local & 3); u.pn = local >> 2; u.ntk = 0; u.kind = 0;
        u.aoff = (long long)u.pm * BM * lda; u.boff = (long long)u.pn * BM * ldb; return true; }
    __device__ __forceinline__ void a_ready(const Unit&) const {}
    __device__ __forceinline__ void done(const Unit&) const {}
};
__device__ __forceinline__ unsigned cvt_pk_bf16(float lo, float hi) { unsigned r; asm volatile("v_cvt_pk_bf16_f32 %0, %1, %2" : "=v"(r) : "v"(lo), "v"(hi)); return r; }
__device__ __forceinline__ f32x2 gelu_pk(f32x2 v) {
    const f32x2 av = __builtin_elementwise_abs(v), d = av * 0.2316418882f + 1.0f;
    f32x2 t; t.x = __builtin_amdgcn_rcpf(d.x); t.y = __builtin_amdgcn_rcpf(d.y);
    f32x2 q = t * 0.5307027145f + (-0.7265760135f); q = q * t + 0.7107068705f; q = q * t + (-0.142248368f); q = q * t + 0.127414796f; q = q * t;
    const f32x2 s = (v * v) * (-0.72134752044f);
    f32x2 e; e.x = __builtin_amdgcn_exp2f(s.x); e.y = __builtin_amdgcn_exp2f(s.y);
    const f32x2 m = v * (q * e), r = v - m;
    f32x2 o; o.x = v.x < 0.f ? m.x : r.x; o.y = v.y < 0.f ? m.y : r.y; return o;
}
__device__ __forceinline__ float sigmoidf_fast(float z) { return __builtin_amdgcn_rcpf(1.0f + __builtin_amdgcn_exp2f(z * -1.4426950408889634f)); }
__device__ __forceinline__ float bf_lo(unsigned w) { return __uint_as_float(w << 16); }
__device__ __forceinline__ float bf_hi(unsigned w) { return __uint_as_float(w & 0xffff0000u); }

struct EpiProj {
    static constexpr bool PERM = true, AFTER_DRAIN = false;
    bf16_t* AG; bf16_t* V; const float* rstd;
    __device__ __forceinline__ void operator()(const f32x4 (&acc)[2][2][4][2], const Unit& u, int wr, int wc, int fr, int fq) const {
        const int row0 = u.pm * BM + wr * 64 + fr, colt = u.pn * BM + wc * 32 + 8 * fq;
        float rsv[2][4];
#pragma unroll
        for (int ai = 0; ai < 2; ++ai)
#pragma unroll
            for (int m = 0; m < 4; ++m) rsv[ai][m] = rstd[row0 + ai * HALF + m * 16];
#pragma unroll
        for (int ai = 0; ai < 2; ++ai)
#pragma unroll
            for (int m = 0; m < 4; ++m) { const int r = row0 + ai * HALF + m * 16; const float rs = rsv[ai][m];
#pragma unroll
                for (int bj = 0; bj < 2; ++bj) { const int c0 = colt + bj * HALF; const f32x4 v0 = acc[ai][bj][m][0] * rs, v1 = acc[ai][bj][m][1] * rs;
                    u32x4 w; w.x = cvt_pk_bf16(v0[0], v0[1]); w.y = cvt_pk_bf16(v0[2], v0[3]); w.z = cvt_pk_bf16(v1[0], v1[1]); w.w = cvt_pk_bf16(v1[2], v1[3]);
                    bf16_t* dst;
                    if (u.pn < 4) { const int g = c0 >> 4, h0 = c0 & 15; dst = AG + ((size_t)(g * 1024 + (r >> 4)) * 384 + (r & 15) * 16 + h0); }
                    else dst = V + (size_t)r * 1024 + (c0 - 1024);
                    *(u32x4*)dst = w; } }
    }
};
struct EpiSloc {
    static constexpr bool PERM = false, AFTER_DRAIN = false;
    float* S;
    __device__ __forceinline__ void operator()(const f32x4 (&acc)[2][2][4][2], const Unit& u, int wr, int wc, int fr, int fq) const {
        const int row0 = u.pm * BM + wr * 64 + fr, col0 = wc * 32 + 4 * fq;
#pragma unroll
        for (int ai = 0; ai < 2; ++ai)
#pragma unroll
            for (int m = 0; m < 4; ++m) { float* rowp = S + (size_t)(row0 + ai * HALF + m * 16) * 128 + col0;
#pragma unroll
                for (int n = 0; n < 2; ++n) *(f32x4*)(rowp + n * 16) = acc[ai][0][m][n]; }
    }
};
struct EpiS5Out {
    static constexpr bool PERM = true, AFTER_DRAIN = false;
    bf16_t* GB;
    __device__ __forceinline__ void operator()(const f32x4 (&acc)[2][2][4][2], const Unit& u, int wr, int wc, int fr, int fq) const {
        const int R0 = u.pm * BM + wr * 64 + fr;
#pragma unroll
        for (int ai = 0; ai < 2; ++ai)
#pragma unroll
            for (int m = 0; m < 4; ++m) { const int R = R0 + ai * HALF + m * 16, g = R >> 10, c = R & 1023;
#pragma unroll
                for (int bj = 0; bj < 2; ++bj) { const int cc = bj * HALF + wc * 32 + 8 * fq, i = cc >> 4, h0 = cc & 15; const f32x4 v0 = acc[ai][bj][m][0], v1 = acc[ai][bj][m][1];
                    const f32x2 a = gelu_pk((f32x2){v0[0], v0[1]}), b = gelu_pk((f32x2){v0[2], v0[3]}), cq = gelu_pk((f32x2){v1[0], v1[1]}), d = gelu_pk((f32x2){v1[2], v1[3]});
                    u32x4 w; w.x = cvt_pk_bf16(a.x, a.y); w.y = cvt_pk_bf16(b.x, b.y); w.z = cvt_pk_bf16(cq.x, cq.y); w.w = cvt_pk_bf16(d.x, d.y);
                    *(u32x4*)(GB + (size_t)(c * 16 + i) * 1024 + g * 16 + h0) = w; } }
    }
};
struct EpiPoolOut {
    static constexpr bool PERM = true, AFTER_DRAIN = false;
    bf16_t* MX; const float* biasp;
    __device__ __forceinline__ void operator()(const f32x4 (&acc)[2][2][4][2], const Unit& u, int wr, int wc, int fr, int fq) const {
        const int row0 = u.pm * BM + wr * 64 + fr, col0 = u.pn * 256 + wc * 32 + 8 * fq;
        f32x4 bv[2][2];
#pragma unroll
        for (int bj = 0; bj < 2; ++bj)
#pragma unroll
            for (int n = 0; n < 2; ++n) bv[bj][n] = *(const f32x4*)(biasp + col0 + bj * HALF + 4 * n);
#pragma unroll
        for (int ai = 0; ai < 2; ++ai)
#pragma unroll
            for (int m = 0; m < 4; ++m) { bf16_t* rowp = MX + (size_t)(row0 + ai * HALF + m * 16) * 2048 + 1024 + col0;
#pragma unroll
                for (int bj = 0; bj < 2; ++bj) { const f32x4 v0 = acc[ai][bj][m][0] + bv[bj][0], v1 = acc[ai][bj][m][1] + bv[bj][1];
                    u32x4 w; w.x = cvt_pk_bf16(v0[0], v0[1]); w.y = cvt_pk_bf16(v0[2], v0[3]); w.z = cvt_pk_bf16(v1[0], v1[1]); w.w = cvt_pk_bf16(v1[2], v1[3]);
                    *(u32x4*)(rowp + bj * HALF) = w; } }
    }
};
struct EpiGlu {
    static constexpr bool PERM = true, AFTER_DRAIN = false;
    bf16_t* MX; const bf16_t* GB; const float* bias;
    __device__ __forceinline__ void operator()(const f32x4 (&acc)[2][2][4][2], const Unit& u, int wr, int wc, int fr, int fq) const {
        const int row0 = u.pm * BM + wr * 64 + fr, col0 = u.pn * BM + wc * 32 + 8 * fq;
        f32x4 bv[2][2];
#pragma unroll
        for (int bj = 0; bj < 2; ++bj)
#pragma unroll
            for (int n = 0; n < 2; ++n) bv[bj][n] = *(const f32x4*)(bias + col0 + bj * HALF + 4 * n);
#pragma unroll
        for (int ai = 0; ai < 2; ++ai) {
            u32x4 gw[4][2];
#pragma unroll
            for (int m = 0; m < 4; ++m)
#pragma unroll
                for (int bj = 0; bj < 2; ++bj) gw[m][bj] = *(const u32x4*)(GB + (size_t)(row0 + ai * HALF + m * 16) * 1024 + col0 + bj * HALF);
#pragma unroll
            for (int m = 0; m < 4; ++m) { const size_t r = (size_t)(row0 + ai * HALF + m * 16);
#pragma unroll
                for (int bj = 0; bj < 2; ++bj) { const u32x4 g4 = gw[m][bj];
                    const f32x4 z0 = acc[ai][bj][m][0] + bv[bj][0], z1 = acc[ai][bj][m][1] + bv[bj][1];
                    const float o0 = bf_lo(g4.x) * sigmoidf_fast(z0[0]), o1 = bf_hi(g4.x) * sigmoidf_fast(z0[1]), o2 = bf_lo(g4.y) * sigmoidf_fast(z0[2]), o3 = bf_hi(g4.y) * sigmoidf_fast(z0[3]);
                    const float o4 = bf_lo(g4.z) * sigmoidf_fast(z1[0]), o5 = bf_hi(g4.z) * sigmoidf_fast(z1[1]), o6 = bf_lo(g4.w) * sigmoidf_fast(z1[2]), o7 = bf_hi(g4.w) * sigmoidf_fast(z1[3]);
                    u32x4 w; w.x = cvt_pk_bf16(o0, o1); w.y = cvt_pk_bf16(o2, o3); w.z = cvt_pk_bf16(o4, o5); w.w = cvt_pk_bf16(o6, o7);
                    *(u32x4*)(MX + r * 2048 + col0 + bj * HALF) = w; } }
            asm volatile("" ::: "memory"); }
    }
};
struct EpiGluPool {
    static constexpr bool PERM = true, AFTER_DRAIN = false;
    EpiGlu a; EpiPoolOut b;
    __device__ __forceinline__ void operator()(const f32x4 (&acc)[2][2][4][2], const Unit& u, int wr, int wc, int fr, int fq) const { if (u.kind == 0) a(acc, u, wr, wc, fr, fq); else b(acc, u, wr, wc, fr, fq); }
};
struct EpiResidA {
    static constexpr bool PERM = true, AFTER_DRAIN = false;
    bf16_t* HB; float* rowss;
    __device__ __forceinline__ void operator()(const f32x4 (&acc)[2][2][4][2], const Unit& u, int wr, int wc, int fr, int fq) const {
        const int row0 = u.pm * BM + wr * 64 + fr, col0 = u.pn * BM + wc * 32 + 8 * fq;
        u32x4 bw[2][4][2];
#pragma unroll
        for (int ai = 0; ai < 2; ++ai)
#pragma unroll
            for (int m = 0; m < 4; ++m)
#pragma unroll
                for (int bj = 0; bj < 2; ++bj) bw[ai][m][bj] = *(const u32x4*)(HB + (size_t)(row0 + ai * HALF + m * 16) * 2048 + col0 + bj * HALF);
#pragma unroll
        for (int ai = 0; ai < 2; ++ai) {
#pragma unroll
            for (int m = 0; m < 4; ++m) { const int r = row0 + ai * HALF + m * 16; const size_t off = (size_t)r * 2048 + col0; float ss = 0.f;
#pragma unroll
                for (int bj = 0; bj < 2; ++bj) { const u32x4 b4 = bw[ai][m][bj]; const f32x4 a0 = acc[ai][bj][m][0], a1 = acc[ai][bj][m][1];
                    const float h0 = bf_lo(b4.x) + a0[0], h1 = bf_hi(b4.x) + a0[1], h2 = bf_lo(b4.y) + a0[2], h3 = bf_hi(b4.y) + a0[3];
                    const float h4 = bf_lo(b4.z) + a1[0], h5 = bf_hi(b4.z) + a1[1], h6 = bf_lo(b4.w) + a1[2], h7 = bf_hi(b4.w) + a1[3];
                    ss += (h0 * h0 + h1 * h1) + (h2 * h2 + h3 * h3) + (h4 * h4 + h5 * h5) + (h6 * h6 + h7 * h7);
                    u32x4 w; w.x = cvt_pk_bf16(h0, h1); w.y = cvt_pk_bf16(h2, h3); w.z = cvt_pk_bf16(h4, h5); w.w = cvt_pk_bf16(h6, h7);
                    *(u32x4*)(HB + off + bj * HALF) = w; }
                ss += __shfl_xor(ss, 16); ss += __shfl_xor(ss, 32);
                if (fq == 0) atomicAdd(rowss + r, ss); }
            asm volatile("" ::: "memory"); }
    }
};
struct EpiFinal {
    static constexpr bool PERM = true, AFTER_DRAIN = false;
    const bf16_t* HB; float* out; float* rowss; unsigned* cnt; unsigned* tmo; const float* gain;
    __device__ __forceinline__ void operator()(f32x4 (&acc)[2][2][4][2], const Unit& u, int wr, int wc, int fr, int fq) const {
        const int row0 = u.pm * BM + wr * 64 + fr, col0 = u.pn * BM + wc * 32 + 8 * fq;
#pragma unroll
        for (int ai = 0; ai < 2; ++ai) {
            u32x4 bw[4][2];
#pragma unroll
            for (int m = 0; m < 4; ++m)
#pragma unroll
                for (int bj = 0; bj < 2; ++bj) bw[m][bj] = *(const u32x4*)(HB + (size_t)(row0 + ai * HALF + m * 16) * 2048 + col0 + bj * HALF);
#pragma unroll
            for (int m = 0; m < 4; ++m) { const int r = row0 + ai * HALF + m * 16; float ss = 0.f;
#pragma unroll
                for (int bj = 0; bj < 2; ++bj) { const u32x4 b4 = bw[m][bj];
                    const f32x4 h0 = acc[ai][bj][m][0] + (f32x4){bf_lo(b4.x), bf_hi(b4.x), bf_lo(b4.y), bf_hi(b4.y)};
                    const f32x4 h1 = acc[ai][bj][m][1] + (f32x4){bf_lo(b4.z), bf_hi(b4.z), bf_lo(b4.w), bf_hi(b4.w)};
                    ss += (h0[0] * h0[0] + h0[1] * h0[1]) + (h0[2] * h0[2] + h0[3] * h0[3]) + (h1[0] * h1[0] + h1[1] * h1[1]) + (h1[2] * h1[2] + h1[3] * h1[3]);
                    acc[ai][bj][m][0] = h0; acc[ai][bj][m][1] = h1; }
                ss += __shfl_xor(ss, 16); ss += __shfl_xor(ss, 32);
                if (fq == 0) atomicAdd(rowss + r, ss); }
            asm volatile("" ::: "memory"); }
        asm volatile("s_waitcnt vmcnt(0)" ::: "memory");
        unsigned* cw = cnt + 64 * u.pm;
        if ((fr | fq) == 0) __hip_atomic_fetch_add(cw, 1u, __ATOMIC_RELAXED, __HIP_MEMORY_SCOPE_AGENT);
        { unsigned sp = 0;
          while ((unsigned)__builtin_amdgcn_readfirstlane(__hip_atomic_load(cw, __ATOMIC_RELAXED, __HIP_MEMORY_SCOPE_AGENT)) < 64u) {
              __builtin_amdgcn_s_sleep(2);
              if (++sp > (1u << 20)) { if ((fr | fq) == 0) __hip_atomic_store(tmo, 1u, __ATOMIC_RELAXED, __HIP_MEMORY_SCOPE_AGENT); break; } } }
        f32x4 gv[2][2]; float rsv[2][4];
#pragma unroll
        for (int bj = 0; bj < 2; ++bj)
#pragma unroll
            for (int n = 0; n < 2; ++n) gv[bj][n] = *(const f32x4*)(gain + col0 + bj * HALF + 4 * n);
#pragma unroll
        for (int ai = 0; ai < 2; ++ai)
#pragma unroll
            for (int m = 0; m < 4; ++m) rsv[ai][m] = __hip_atomic_load(rowss + row0 + ai * HALF + m * 16, __ATOMIC_RELAXED, __HIP_MEMORY_SCOPE_AGENT);
#pragma unroll
        for (int ai = 0; ai < 2; ++ai)
#pragma unroll
            for (int m = 0; m < 4; ++m) { const int r = row0 + ai * HALF + m * 16; const size_t off = (size_t)r * 2048 + col0;
                const float rs = 1.0f / sqrtf(rsv[ai][m] * (1.0f / 2048.0f) + 1e-6f);
#pragma unroll
                for (int bj = 0; bj < 2; ++bj) { *(f32x4*)(out + off + bj * HALF) = acc[ai][bj][m][0] * rs * gv[bj][0]; *(f32x4*)(out + off + bj * HALF + 4) = acc[ai][bj][m][1] * rs * gv[bj][1]; } }
    }
};
struct EpiSwiglu {
    static constexpr bool PERM = true, AFTER_DRAIN = false;
    bf16_t* FF; const float* rowss;
    __device__ __forceinline__ void operator()(const f32x4 (&acc)[2][2][4][2], const Unit& u, int wr, int wc, int fr, int fq) const {
        const int row0 = u.pm * BM + wr * 64 + fr, col0 = u.pn * HALF + wc * 32 + 8 * fq;
        float rsv[2][4];
#pragma unroll
        for (int ai = 0; ai < 2; ++ai)
#pragma unroll
            for (int m = 0; m < 4; ++m) rsv[ai][m] = __hip_atomic_load(rowss + row0 + ai * HALF + m * 16, __ATOMIC_RELAXED, __HIP_MEMORY_SCOPE_AGENT);
#pragma unroll
        for (int ai = 0; ai < 2; ++ai)
#pragma unroll
            for (int m = 0; m < 4; ++m) { const int r = row0 + ai * HALF + m * 16;
                const float rs = 1.0f / sqrtf(rsv[ai][m] * (1.0f / 2048.0f) + 1e-6f);
                const float c1 = rs * -1.4426950408889634f, c2 = rs * rs;
                f32x2 o[4];
#pragma unroll
                for (int n = 0; n < 2; ++n)
#pragma unroll
                    for (int hh = 0; hh < 2; ++hh) { const f32x2 g2 = (f32x2){acc[ai][0][m][n][2 * hh], acc[ai][0][m][n][2 * hh + 1]}, u2 = (f32x2){acc[ai][1][m][n][2 * hh], acc[ai][1][m][n][2 * hh + 1]};
                        const f32x2 z = g2 * c1; f32x2 e; e.x = __builtin_amdgcn_exp2f(z.x); e.y = __builtin_amdgcn_exp2f(z.y);
                        const f32x2 d = e + 1.0f; f32x2 q; q.x = __builtin_amdgcn_rcpf(d.x); q.y = __builtin_amdgcn_rcpf(d.y);
                        o[n * 2 + hh] = ((g2 * u2) * c2) * q; }
                u32x4 w; w.x = cvt_pk_bf16(o[0].x, o[0].y); w.y = cvt_pk_bf16(o[1].x, o[1].y); w.z = cvt_pk_bf16(o[2].x, o[2].y); w.w = cvt_pk_bf16(o[3].x, o[3].y);
                *(u32x4*)(FF + (size_t)r * 5632 + col0) = w; }
    }
};

template <class Epi, class Sched, bool ALIGN_EPI = false, bool SP2 = false>
__device__ __forceinline__ void gemm_phase(PG8_LAS unsigned char* lds, const Gemm g, const Sched& S, const Epi& E) {
    int tid = threadIdx.x; asm volatile("" : "+v"(tid));
    const int wid = __builtin_amdgcn_readfirstlane(tid >> 6), lane = tid & 63, wr = wid >> 2, wc = wid & 3, fr = lane & 15, fq = lane >> 4;
    const int ntg = g.K / BK;
    unsigned voffA[2], voffB[2];
#pragma unroll
    for (int i = 0; i < 2; ++i) { int R, C; stage_rc(tid * 16 + i * 8192, R, C); const int Rb = Epi::PERM ? ((R & ~31) + perm32(R & 31)) : R;
        voffA[i] = (unsigned)(R * g.lda + C) * 2u; voffB[i] = (unsigned)(Rb * g.ldb + C) * 2u; }
    const size_t kstep = (size_t)(BK * 2);
    const size_t hstepA = (size_t)HALF * g.lda * 2, hstepB = (size_t)g.hsB * g.ldb * 2;
    const unsigned ldsw = (unsigned)wid * 1024u;
    const int aoff = lds_byte(wr * 64 + fr, fq * 8), boff = lds_byte(wc * 32 + fr, fq * 8);
#define PG8_SA(b, h) (((b) * 2 + (h)) * HTB)
#define PG8_SB(b, h) ((4 + (b) * 2 + (h)) * HTB)
#define PG8_STAGE(bufoff, gbase, voff) do { _Pragma("unroll") for (int _i = 0; _i < 2; ++_i) \
        __builtin_amdgcn_global_load_lds((const unsigned*)((const char*)(gbase) + (voff)[_i]), (PG8_LAS unsigned*)(lds + (bufoff) + ldsw + _i * 8192), 16, 0, 0); } while (0)
#define PG8_LDA(dst, b, h) do { _Pragma("unroll") for (int m = 0; m < 4; ++m) _Pragma("unroll") for (int k = 0; k < 2; ++k) dst[m][k] = *(const PG8_LAS bf16x8*)(lds + PG8_SA(b, h) + aoff + m * 2048 + k * 1024); } while (0)
#define PG8_LDB(dst, b, h) do { _Pragma("unroll") for (int n = 0; n < 2; ++n) _Pragma("unroll") for (int k = 0; k < 2; ++k) dst[n][k] = *(const PG8_LAS bf16x8*)(lds + PG8_SB(b, h) + boff + n * 2048 + k * 1024); } while (0)
#define PG8_MMA(ai, bj, At, Bt) do { __builtin_amdgcn_s_setprio(1); _Pragma("unroll") for (int m = 0; m < 4; ++m) _Pragma("unroll") for (int n = 0; n < 2; ++n) _Pragma("unroll") for (int k = 0; k < 2; ++k) \
        acc[ai][bj][m][n] = __builtin_amdgcn_mfma_f32_16x16x32_bf16(Bt[n][k], At[m][k], acc[ai][bj][m][n], 0, 0, 0); __builtin_amdgcn_s_setprio(0); } while (0)
#define PG8_WAIT_V(n) asm volatile("s_waitcnt vmcnt(" #n ")" ::: "memory")
#define PG8_WAIT_L(n) asm volatile("s_waitcnt lgkmcnt(" #n ")" ::: "memory")
#define PG8_BAR __builtin_amdgcn_s_barrier()
#define PG8_SCHED __builtin_amdgcn_sched_barrier(0)
    Unit cur, nxt; int ui = 0;
    if (!S.next(0, cur)) return;
    f32x4 acc[2][2][4][2];
#pragma unroll
    for (int a = 0; a < 2; ++a)
#pragma unroll
        for (int b = 0; b < 2; ++b)
#pragma unroll
            for (int m = 0; m < 4; ++m)
#pragma unroll
                for (int n = 0; n < 2; ++n) acc[a][b][m][n] = (f32x4){0.f, 0.f, 0.f, 0.f};
    bf16x8 At[4][2], B0[2][2], B1[2][2];
    const char* cA = (const char*)g.A + cur.aoff * 2; const char* cB = (const char*)g.Bt + cur.boff * 2;
    S.a_ready(cur);
    if constexpr (SP2) {
        PG8_STAGE(PG8_SB(0, 0), cB, voffB); PG8_STAGE(PG8_SB(0, 1), cB + hstepB, voffB); PG8_STAGE(PG8_SA(0, 0), cA, voffA); PG8_STAGE(PG8_SA(0, 1), cA + hstepA, voffA);
        if (wr == 1) PG8_BAR;
        PG8_WAIT_V(2); PG8_BAR;
        PG8_STAGE(PG8_SB(1, 0), cB + kstep, voffB); PG8_STAGE(PG8_SA(1, 0), cA + kstep, voffA); PG8_STAGE(PG8_SB(1, 1), cB + hstepB + kstep, voffB);
        PG8_WAIT_V(6); PG8_BAR;
    } else {
        PG8_STAGE(PG8_SB(0, 0), cB, voffB); PG8_STAGE(PG8_SA(0, 0), cA, voffA); PG8_STAGE(PG8_SB(0, 1), cB + hstepB, voffB); PG8_STAGE(PG8_SA(0, 1), cA + hstepA, voffA);
        if (wr == 1) PG8_BAR;
        PG8_WAIT_V(4); PG8_BAR;
        PG8_STAGE(PG8_SB(1, 0), cB + kstep, voffB); PG8_STAGE(PG8_SA(1, 0), cA + kstep, voffA); PG8_STAGE(PG8_SB(1, 1), cB + hstepB + kstep, voffB);
        PG8_WAIT_V(6); PG8_BAR;
    }
    for (;;) {
        const bool has_next = S.next(ui + 1, nxt);
        const char* nA = has_next ? (const char*)g.A + nxt.aoff * 2 : cA; const char* nB = has_next ? (const char*)g.Bt + nxt.boff * 2 : cB;
        const int nt = cur.ntk ? cur.ntk : ntg;
        for (int t = 0; t < nt; t += 2) {
            const bool last = (t == nt - 2);
            const char* a1 = cA + (size_t)(t + 1) * kstep;
            const char* a2 = last ? nA : cA + (size_t)(t + 2) * kstep; const char* b2 = last ? nB : cB + (size_t)(t + 2) * kstep;
            const char* a3 = a2 + kstep; const char* b3 = b2 + kstep;
            if (last && has_next) S.a_ready(nxt);
            if constexpr (SP2) {
            PG8_LDB(B0, 0, 0); PG8_LDB(B1, 0, 1); PG8_SCHED; PG8_LDA(At, 0, 0); PG8_STAGE(PG8_SA(1, 1), a1 + hstepA, voffA);
            PG8_WAIT_V(8); PG8_WAIT_L(0); PG8_BAR; PG8_MMA(0, 0, At, B0); PG8_MMA(0, 1, At, B1); PG8_BAR; PG8_SCHED;
            PG8_LDA(At, 0, 1); PG8_STAGE(PG8_SB(0, 0), b2, voffB); PG8_STAGE(PG8_SB(0, 1), b2 + hstepB, voffB); PG8_STAGE(PG8_SA(0, 0), a2, voffA);
            PG8_WAIT_V(8); PG8_WAIT_L(0); PG8_BAR; PG8_MMA(1, 0, At, B0); PG8_MMA(1, 1, At, B1); PG8_BAR; PG8_SCHED;
            PG8_LDB(B0, 1, 0); PG8_LDB(B1, 1, 1); PG8_SCHED; PG8_LDA(At, 1, 0); PG8_STAGE(PG8_SA(0, 1), a2 + hstepA, voffA);
            PG8_WAIT_V(8); PG8_WAIT_L(0); PG8_BAR; PG8_MMA(0, 0, At, B0); PG8_MMA(0, 1, At, B1); PG8_BAR; PG8_SCHED;
            PG8_LDA(At, 1, 1); PG8_STAGE(PG8_SB(1, 0), b3, voffB); PG8_STAGE(PG8_SB(1, 1), b3 + hstepB, voffB); PG8_STAGE(PG8_SA(1, 0), a3, voffA);
            PG8_WAIT_V(8); PG8_WAIT_L(0); PG8_BAR; PG8_MMA(1, 0, At, B0); PG8_MMA(1, 1, At, B1); PG8_BAR; PG8_SCHED;
            } else {
            PG8_LDB(B0, 0, 0); PG8_SCHED; PG8_LDA(At, 0, 0); PG8_STAGE(PG8_SA(1, 1), a1 + hstepA, voffA);
            PG8_WAIT_L(8); PG8_BAR; PG8_WAIT_L(0); PG8_MMA(0, 0, At, B0); PG8_BAR; PG8_SCHED;
            PG8_LDB(B1, 0, 1); PG8_STAGE(PG8_SB(0, 0), b2, voffB);
            PG8_BAR; PG8_WAIT_L(0); PG8_MMA(0, 1, At, B1); PG8_BAR;
            PG8_LDA(At, 0, 1); PG8_STAGE(PG8_SA(0, 0), a2, voffA);
            PG8_BAR; PG8_WAIT_L(0); PG8_MMA(1, 0, At, B0); PG8_BAR; PG8_SCHED;
            PG8_STAGE(PG8_SB(0, 1), b2 + hstepB, voffB);
            PG8_WAIT_V(6); PG8_BAR; PG8_MMA(1, 1, At, B1); PG8_BAR;
            PG8_LDB(B0, 1, 0); PG8_SCHED; PG8_LDA(At, 1, 0); PG8_STAGE(PG8_SA(0, 1), a2 + hstepA, voffA);
            PG8_WAIT_L(8); PG8_BAR; PG8_WAIT_L(0); PG8_MMA(0, 0, At, B0); PG8_BAR; PG8_SCHED;
            PG8_LDB(B1, 1, 1); PG8_STAGE(PG8_SB(1, 0), b3, voffB);
            PG8_BAR; PG8_WAIT_L(0); PG8_MMA(0, 1, At, B1); PG8_BAR;
            PG8_LDA(At, 1, 1); PG8_STAGE(PG8_SA(1, 0), a3, voffA);
            PG8_BAR; PG8_WAIT_L(0); PG8_MMA(1, 0, At, B0); PG8_BAR; PG8_SCHED;
            PG8_STAGE(PG8_SB(1, 1), b3 + hstepB, voffB);
            PG8_WAIT_V(6); PG8_BAR; PG8_MMA(1, 1, At, B1); PG8_BAR;
            }
        }
        if constexpr (ALIGN_EPI) { if (wr == 0) PG8_BAR; }
        if constexpr (!Epi::AFTER_DRAIN) { int fr2 = fr, fq2 = fq; asm volatile("" : "+v"(fr2), "+v"(fq2));
            E(acc, cur, wr, wc, fr2, fq2); S.done(cur); }
        if (!has_next) break;
#pragma unroll
        for (int a = 0; a < 2; ++a)
#pragma unroll
            for (int b = 0; b < 2; ++b)
#pragma unroll
                for (int m = 0; m < 4; ++m)
#pragma unroll
                    for (int n = 0; n < 2; ++n) acc[a][b][m][n] = (f32x4){0.f, 0.f, 0.f, 0.f};
        cur = nxt; cA = nA; cB = nB; ++ui;
        if constexpr (ALIGN_EPI) { if (wr == 1) PG8_BAR; }
    }
    PG8_WAIT_V(0);
    if constexpr (!ALIGN_EPI) { if (wr == 0) PG8_BAR; }
    PG8_BAR;
#undef PG8_SA
#undef PG8_SB
#undef PG8_STAGE
#undef PG8_LDA
#undef PG8_LDB
#undef PG8_MMA
#undef PG8_WAIT_V
#undef PG8_WAIT_L
#undef PG8_BAR
#undef PG8_SCHED
}
}

#ifndef WGM_P1
#define WGM_P1 4
#endif
#ifndef WGM_P5
#define WGM_P5 4
#endif
#ifndef WGM_P6
#define WGM_P6 4
#endif
#ifndef WGM_P7
#define WGM_P7 4
#endif
#ifndef PG8_SP2
#define PG8_SP2 true
#endif
#ifndef PG8_ALIGN
#define PG8_ALIGN true
#endif

constexpr int NWAVES = 8;
constexpr int SEQ = 16384, DM = 2048, SSMW = 1024, NGRP = 64, NST = 64, NHC = 16, DFF = 5632, TCH = 16, NCHK = SEQ / TCH, AGK = 384;
constexpr size_t MiB = 1u << 20;
constexpr size_t WS_CTL = 0, CTL_ZERO_BYTES = 1 * MiB;
constexpr size_t WS_WIN = 1 * MiB, WS_WGLU = 9 * MiB, WS_WPOOL = 406 * MiB, WS_BIASP = 11 * MiB + 512 * 1024, WS_LT = WS_BIASP + 64 * 1024, WS_RSTD1 = WS_BIASP + 128 * 1024, WS_XE = WS_BIASP + 256 * 1024;
constexpr size_t WS_WOUT = 12 * MiB, WS_WGU = 20 * MiB, WS_WDOWN = 64 * MiB, WS_BTA = 86 * MiB, WS_BTB = 90 * MiB, WS_XB = 102 * MiB;
constexpr size_t WS_AG = 166 * MiB, WS_V = 214 * MiB, WS_SLOC = 246 * MiB, WS_GBUF = 278 * MiB, WS_POOLED = 310 * MiB, WS_FF = 166 * MiB, WS_MIXED = 342 * MiB, WS_END = 408 * MiB;
static_assert(WS_FF + (size_t)SEQ * DFF * 2 <= WS_MIXED && WS_AG + (size_t)NGRP * NCHK * AGK * 2 <= WS_V && WS_BTB + (size_t)NGRP * 256 * AGK * 2 <= WS_XB && WS_WDOWN + (size_t)DM * DFF * 2 <= WS_BTA, "ws map");
constexpr int CW_TMO = 0, CW_BAR = 4096, CW_PANEL = 196608, CW_XF = 212992;
constexpr size_t CTL_ROWSS2 = 256 * 1024, CTL_ROWSS3 = 512 * 1024;
constexpr int RING_OFF = 0, RING_BYTES = 131072, LDSCTL_OFF = RING_BYTES, MISC_OFF = LDSCTL_OFF + 320, LDS_BYTES = 147456;
constexpr int N_PHASES = 9;

#define LAS __attribute__((address_space(3)))
typedef unsigned short bf16;
typedef unsigned v4u __attribute__((ext_vector_type(4)));
typedef unsigned v2u __attribute__((ext_vector_type(2)));
typedef float f32x4 __attribute__((ext_vector_type(4)));
#define LDS_WAIT() asm volatile("s_waitcnt lgkmcnt(0)" ::: "memory")
#define VM_WAIT() asm volatile("s_waitcnt vmcnt(0)" ::: "memory")
__device__ __forceinline__ unsigned f2bf(float f) { unsigned u = __builtin_bit_cast(unsigned, f); return (u + 0x7fffu + ((u >> 16) & 1u)) >> 16; }
__device__ __forceinline__ unsigned pk2(float lo, float hi) { return f2bf(lo) | (f2bf(hi) << 16); }

#define XB_TMO      128
#define XB_XCNT(j)  (256  + 64 * (j))
#define XB_XSUB(j)  (1280 + 64 * (j))
#define XB_XGEN(j)  (2304 + 64 * (j))
#define XB_TOP      3328
#define XB_TOPGEN   3392
#define XCD_BAR_WORDS 3456
#define XB_SPIN_CAP (1u << 18)
__device__ __forceinline__ unsigned xb_ld(unsigned* p)              { return __hip_atomic_load(p, __ATOMIC_RELAXED, __HIP_MEMORY_SCOPE_AGENT); }
__device__ __forceinline__ unsigned xb_add(unsigned* p, unsigned v) { return __hip_atomic_fetch_add(p, v, __ATOMIC_RELAXED, __HIP_MEMORY_SCOPE_AGENT); }
__device__ __forceinline__ unsigned xb_xcc_id() { return (unsigned)__builtin_amdgcn_s_getreg((3 << 11) | 20) & 0xFu; }
#define XB_SPIN(cond, bar) do { unsigned _sp = 0; while (cond) { __builtin_amdgcn_s_sleep(1); \
    if ((++_sp & 255u) == 0u) { if (xb_ld(&(bar)[XB_TMO])) break; if (_sp > XB_SPIN_CAP) { atomicAdd(&(bar)[XB_TMO], 1u); break; } } } } while (0)
struct XcdBarrier { unsigned* bar; unsigned x; volatile LAS unsigned* st; };
__device__ __forceinline__ XcdBarrier xcd_barrier_post(unsigned* bar, volatile LAS unsigned* st) {
    XcdBarrier b; b.bar = bar; b.x = xb_xcc_id(); b.st = st;
    if (threadIdx.x == 0) (void)xb_add(&bar[XB_XCNT(b.x)], 1u);
    return b;
}
__device__ __forceinline__ void xcd_barrier_complete(unsigned* bar, unsigned x, unsigned& nloc, unsigned& nx) {
    const unsigned G = gridDim.x * gridDim.y * gridDim.z;
    unsigned sum, cnt, mine, sp = 0u;
    for (;;) {
        sum = 0u; cnt = 0u; mine = 0u;
#pragma unroll
        for (unsigned j = 0; j < 16; ++j) { const unsigned c = xb_ld(&bar[XB_XCNT(j)]); sum += c; cnt += (c > 0u) ? 1u : 0u; mine = (j == x) ? c : mine; }
        if (sum == G) break;
        __builtin_amdgcn_s_sleep(1);
        if ((++sp & 255u) == 0u) { if (xb_ld(&bar[XB_TMO])) break; if (sp > XB_SPIN_CAP) { atomicAdd(&bar[XB_TMO], 1u); break; } }
    }
    nloc = mine > 0u ? mine : 1u; nx = cnt > 0u ? cnt : 1u;
}
__device__ __forceinline__ void xcd_barrier_protocol(const XcdBarrier& b) {
    unsigned* bar = b.bar;
    __builtin_amdgcn_s_waitcnt(0);
    unsigned nloc = b.st[0], nx = b.st[1];
    if (nloc == 0u) { xcd_barrier_complete(bar, b.x, nloc, nx); b.st[0] = nloc; b.st[1] = nx; }
    const unsigned old = xb_add(&bar[XB_XSUB(b.x)], 1u);
    const unsigned gen = old / nloc;
    if (old + 1u == (gen + 1u) * nloc) {
        __builtin_amdgcn_fence(__ATOMIC_RELEASE, "agent");
        asm volatile("s_waitcnt vmcnt(0)" ::: "memory");
        const unsigned og = xb_add(&bar[XB_TOP], 1u);
        const unsigned tg = og / nx;
        if (og + 1u == (tg + 1u) * nx) xb_add(&bar[XB_TOPGEN], 1u);
        else XB_SPIN(xb_ld(&bar[XB_TOPGEN]) == tg, bar);
        __builtin_amdgcn_fence(__ATOMIC_ACQUIRE, "agent");
        xb_add(&bar[XB_XGEN(b.x)], 1u);
        asm volatile("s_waitcnt vmcnt(0)" ::: "memory");
    } else {
        XB_SPIN(xb_ld(&bar[XB_XGEN(b.x)]) == gen, bar);
        __builtin_amdgcn_fence(__ATOMIC_ACQUIRE, "agent");
        asm volatile("s_waitcnt vmcnt(0)" ::: "memory");
    }
}
__device__ __forceinline__ void xcd_barrier(const XcdBarrier& b) {
    asm volatile("s_waitcnt vmcnt(0)" ::: "memory");
    __syncthreads();
    if (threadIdx.x == 0) xcd_barrier_protocol(b);
    __syncthreads();
}

__device__ __forceinline__ float wave_sum(float v) {
#pragma unroll
    for (int o = 1; o < 64; o <<= 1) v += __shfl_xor(v, o);
    return v;
}

struct TItem { const float* W; bf16* WT; const float* ks; const float* ns; int N, ldt, orow, k0, n0; float kson, nson; };
__device__ __forceinline__ void titem_decode(int it, TItem& d, const float* const* in, bf16* WIN, bf16* WGLU, bf16* WPOOL, bf16* WOUT, bf16* WGU, bf16* WDOWN) {
    constexpr int I_IN = 32 * 64, I_GLU = 16 * 32, I_POOL = 4 * 32, I_OUT = 32 * 64, I_G = 32 * 176;
    int r = it; d.ks = in[1]; d.ns = in[1]; d.kson = 0.f; d.nson = 0.f;
    if (r < I_IN) { const int kb = r / 64, nb = r % 64; d.W = in[2]; d.N = DM; d.WT = WIN; d.ldt = DM; d.orow = 32 * nb; d.k0 = 64 * kb; d.n0 = 32 * nb; d.ks = in[1]; d.kson = 1.f; return; } r -= I_IN;
    if (r < I_GLU) { const int kb = r / 32, nb = r % 32; d.W = in[11]; d.N = SSMW; d.WT = WGLU; d.ldt = SSMW; d.orow = 32 * nb; d.k0 = 64 * kb; d.n0 = 32 * nb; return; } r -= I_GLU;
    if (r < I_POOL) { const int kg = r / 32, q = r % 32, kb = q / 8, nb = q % 8; d.W = in[13] + (size_t)kg * 65536; d.N = 256; d.WT = WPOOL + (size_t)kg * 256 * 1024; d.ldt = 1024; d.orow = 32 * nb; d.k0 = 64 * kb; d.n0 = 32 * nb;
        d.ns = in[15] + kg * 256; d.nson = 1.f; return; } r -= I_POOL;
    if (r < I_OUT) { const int kb = r / 64, nb = r % 64; d.W = in[16]; d.N = DM; d.WT = WOUT; d.ldt = DM; d.orow = 32 * nb; d.k0 = 64 * kb; d.n0 = 32 * nb; return; } r -= I_OUT;
    if (r < I_G) { const int kb = r / 176, nb = r % 176, n0 = 32 * nb; d.W = in[18]; d.N = DFF; d.WT = WGU; d.ldt = DM; d.orow = (n0 >> 7) * 256 + (n0 & 127); d.k0 = 64 * kb; d.n0 = n0; d.ks = in[17]; d.kson = 1.f; return; } r -= I_G;
    if (r < I_G) { const int kb = r / 176, nb = r % 176, n0 = 32 * nb; d.W = in[19]; d.N = DFF; d.WT = WGU; d.ldt = DM; d.orow = (n0 >> 7) * 256 + 128 + (n0 & 127); d.k0 = 64 * kb; d.n0 = n0; d.ks = in[17]; d.kson = 1.f; return; } r -= I_G;
    { const int kb = r / 64, nb = r % 64; d.W = in[20]; d.N = DM; d.WT = WDOWN; d.ldt = DFF; d.orow = 32 * nb; d.k0 = 64 * kb; d.n0 = 32 * nb; }
}
__device__ __forceinline__ void titem_load(const TItem& d, float (&v)[32], int lane) {
#pragma unroll
    for (int i = 0; i < 32; ++i) { const int kk = 2 * i + (lane >> 5); v[i] = __builtin_nontemporal_load(d.W + ((size_t)(d.k0 + kk) * d.N + d.n0 + (lane & 31))); }
}
__device__ __forceinline__ void titem_store(const TItem& d, const float (&v)[32], LAS float* scr, int lane) {
#pragma unroll
    for (int i = 0; i < 32; ++i) { const int kk = 2 * i + (lane >> 5); const float sc = d.ks[(d.k0 + kk) & 2047] * d.kson + (1.0f - d.kson); scr[kk * 33 + (lane & 31)] = v[i] * sc; }
    LDS_WAIT(); asm volatile("" ::: "memory");
    const int c = lane & 7;
#pragma unroll
    for (int j = 0; j < 4; ++j) { const int n = (lane >> 3) + 8 * j; const LAS float* s = scr + (8 * c) * 33 + n; const float sc = d.ns[(d.n0 + n) & 255] * d.nson + (1.0f - d.nson);
        v4u o; o.x = pk2(s[0 * 33] * sc, s[1 * 33] * sc); o.y = pk2(s[2 * 33] * sc, s[3 * 33] * sc); o.z = pk2(s[4 * 33] * sc, s[5 * 33] * sc); o.w = pk2(s[6 * 33] * sc, s[7 * 33] * sc);
        *(v4u*)(d.WT + (size_t)(d.orow + n) * d.ldt + d.k0 + 8 * c) = o; }
    LDS_WAIT(); asm volatile("" ::: "memory");
}
__device__ __forceinline__ void titem_run(int it, const float* const* in, bf16* WIN, bf16* WGLU, bf16* WPOOL, bf16* WOUT, bf16* WGU, bf16* WDOWN, LAS float* scr, int lane) {
    TItem d; float v[32]; titem_decode(it, d, in, WIN, WGLU, WPOOL, WOUT, WGU, WDOWN); titem_load(d, v, lane); titem_store(d, v, scr, lane);
}
__device__ __forceinline__ void x_rows2_to_bf16(const float* x, bf16* XBp, float* rstd, int m0, int m1, int lane) {
    const f32x4* xa = (const f32x4*)(x + (size_t)m0 * DM) + lane; const f32x4* xc = (const f32x4*)(x + (size_t)m1 * DM) + lane; f32x4 va[8], vc[8];
#pragma unroll
    for (int j = 0; j < 8; ++j) va[j] = __builtin_nontemporal_load(xa + 64 * j);
#pragma unroll
    for (int j = 0; j < 8; ++j) vc[j] = __builtin_nontemporal_load(xc + 64 * j);
    float sa = 0.f, sc = 0.f;
#pragma unroll
    for (int j = 0; j < 8; ++j) { sa += (va[j].x * va[j].x + va[j].y * va[j].y) + (va[j].z * va[j].z + va[j].w * va[j].w); sc += (vc[j].x * vc[j].x + vc[j].y * vc[j].y) + (vc[j].z * vc[j].z + vc[j].w * vc[j].w); }
    sa = wave_sum(sa); sc = wave_sum(sc);
    if (lane == 0) { rstd[m0] = 1.0f / sqrtf(sa * (1.0f / DM) + 1e-6f); rstd[m1] = 1.0f / sqrtf(sc * (1.0f / DM) + 1e-6f); }
    v2u* oa = (v2u*)(XBp + (size_t)m0 * DM) + lane; v2u* oc = (v2u*)(XBp + (size_t)m1 * DM) + lane;
#pragma unroll
    for (int j = 0; j < 8; ++j) { v2u w; w.x = pk2(va[j].x, va[j].y); w.y = pk2(va[j].z, va[j].w); oa[64 * j] = w; }
#pragma unroll
    for (int j = 0; j < 8; ++j) { v2u w; w.x = pk2(vc[j].x, vc[j].y); w.y = pk2(vc[j].z, vc[j].w); oc[64 * j] = w; }
}
__device__ __forceinline__ void s5_tables_group(int g, LAS unsigned char* lds, int tid, const float* lre, const float* lim, const float* lstep, const float* bre, const float* bim,
                                                const float* cre, const float* cim, const float* dsk, bf16* BtA, bf16* BtB, float* LT) {
    LAS float* Lp = (LAS float*)lds;
    LAS float* Bb = Lp + 17 * 64 * 2;
    LAS float* Cc = Bb + 2048;
    LAS float* Kt = Cc + 2048;
    if (tid < 64) { const int p = tid;
        const double step = exp((double)lstep[g]), lr = lre[g * 64 + p], li = lim[g * 64 + p];
        const double er = exp(lr * step), Lr = er * cos(li * step), Li = er * sin(li * step);
        double pr = 1.0, pi = 0.0;
        for (int tau = 0; tau <= 16; ++tau) { Lp[(tau * 64 + p) * 2] = (float)pr; Lp[(tau * 64 + p) * 2 + 1] = (float)pi; const double nr = pr * Lr - pi * Li, ni = pr * Li + pi * Lr; pr = nr; pi = ni; }
        LT[(g * 64 + p) * 2] = Lp[(16 * 64 + p) * 2]; LT[(g * 64 + p) * 2 + 1] = Lp[(16 * 64 + p) * 2 + 1];
        const double nr = Lr - 1.0, ni = Li, den = lr * lr + li * li, qr = (nr * lr + ni * li) / den, qi = (ni * lr - nr * li) / den;
        for (int h = 0; h < 16; ++h) { const double br = bre[(g * 64 + p) * 16 + h], bi = bim[(g * 64 + p) * 16 + h];
            Bb[(p * 16 + h) * 2] = (float)(qr * br - qi * bi); Bb[(p * 16 + h) * 2 + 1] = (float)(qr * bi + qi * br); } }
    for (int idx = tid; idx < 1024; idx += 512) { Cc[idx * 2] = cre[g * 1024 + idx]; Cc[idx * 2 + 1] = cim[g * 1024 + idx]; }
    __syncthreads();
    for (int e = tid; e < 4096; e += 512) { const int tau = e >> 8, hp = (e >> 4) & 15, h = e & 15; float sum = 0.f;
        for (int p = 0; p < 64; ++p) { const float cr = Cc[(hp * 64 + p) * 2], ci = Cc[(hp * 64 + p) * 2 + 1], lr = Lp[(tau * 64 + p) * 2], li = Lp[(tau * 64 + p) * 2 + 1];
            const float er = cr * lr - ci * li, ei = cr * li + ci * lr; sum += er * Bb[(p * 16 + h) * 2] - ei * Bb[(p * 16 + h) * 2 + 1]; }
        if (tau == 0 && hp == h) sum += dsk[g * 16 + h];
        Kt[e] = sum; }
    __syncthreads();
    for (int e = tid; e < 256 * 192; e += 512) { const int row = e / 192, col = 2 * (e % 192), i = row >> 4, hp = row & 15; float v0, v1;
        if (col < 256) { const int j = col >> 4, h = col & 15; v0 = j <= i ? Kt[((i - j) * 16 + hp) * 16 + h] : 0.f; v1 = j <= i ? Kt[((i - j) * 16 + hp) * 16 + h + 1] : 0.f; }
        else { const int im = col >= 320, p = (col - 256) & 63; float e0, e1;
            { const float cr = Cc[(hp * 64 + p) * 2], ci = Cc[(hp * 64 + p) * 2 + 1], lr = Lp[((i + 1) * 64 + p) * 2], li = Lp[((i + 1) * 64 + p) * 2 + 1]; e0 = im ? -(cr * li + ci * lr) : (cr * lr - ci * li); }
            { const float cr = Cc[(hp * 64 + p + 1) * 2], ci = Cc[(hp * 64 + p + 1) * 2 + 1], lr = Lp[((i + 1) * 64 + p + 1) * 2], li = Lp[((i + 1) * 64 + p + 1) * 2 + 1]; e1 = im ? -(cr * li + ci * lr) : (cr * lr - ci * li); }
            v0 = e0; v1 = e1; }
        *(unsigned*)(BtB + ((size_t)(g * 256 + row)) * AGK + col) = pk2(v0, v1); }
    for (int e = tid; e < 128 * 128; e += 512) { const int q = e >> 7, col = 2 * (e & 127), p = q & 63, im = q >> 6, j = col >> 4, h = col & 15;
        const float lr = Lp[((15 - j) * 64 + p) * 2], li = Lp[((15 - j) * 64 + p) * 2 + 1];
        const float b0r = Bb[(p * 16 + h) * 2], b0i = Bb[(p * 16 + h) * 2 + 1], b1r = Bb[(p * 16 + h + 1) * 2], b1i = Bb[(p * 16 + h + 1) * 2 + 1];
        const float v0 = im ? (lr * b0i + li * b0r) : (lr * b0r - li * b0i), v1 = im ? (lr * b1i + li * b1r) : (lr * b1r - li * b1i);
        *(unsigned*)(BtA + ((size_t)(g * 128 + q)) * 256 + col) = pk2(v0, v1); }
    __syncthreads();
}
__device__ __forceinline__ void s5_scan_item(int w, LAS unsigned char* lds, int tid, const float* SLOC, const float* LT, bf16* AG) {
    const int g = w >> 2, p = (w & 3) * 16 + (tid & 15), seg = tid >> 4, pl = tid & 15;
    const float Lr = LT[(g * 64 + p) * 2], Li = LT[(g * 64 + p) * 2 + 1];
    const float* base = SLOC + ((size_t)(g * NCHK + seg * 32)) * 128 + p;
    float ar[32], ai[32];
#pragma unroll
    for (int k = 0; k < 32; ++k) { ar[k] = base[(size_t)k * 128]; ai[k] = base[(size_t)k * 128 + 64]; }
    float sr = 0.f, si = 0.f;
#pragma unroll
    for (int k = 0; k < 32; ++k) { const float tr = ar[k], ti = ai[k]; ar[k] = sr; ai[k] = si; const float nr = Lr * sr - Li * si + tr, ni = Lr * si + Li * sr + ti; sr = nr; si = ni; }
    LAS float* End = (LAS float*)lds;
    End[(seg * 16 + pl) * 2] = sr; End[(seg * 16 + pl) * 2 + 1] = si;
    __syncthreads();
    float Mr = Lr, Mi = Li;
#pragma unroll
    for (int q = 0; q < 5; ++q) { const float nr = Mr * Mr - Mi * Mi, ni = 2.f * Mr * Mi; Mr = nr; Mi = ni; }
    float cr = 0.f, ci = 0.f;
    for (int s2 = 0; s2 < seg; ++s2) { const float er = End[(s2 * 16 + pl) * 2], ei = End[(s2 * 16 + pl) * 2 + 1]; const float nr = Mr * cr - Mi * ci + er, ni = Mr * ci + Mi * cr + ei; cr = nr; ci = ni; }
    bf16* dst = AG + ((size_t)(g * NCHK + seg * 32)) * AGK + 256 + p;
#pragma unroll
    for (int k = 0; k < 32; ++k) { dst[(size_t)k * AGK] = (bf16)f2bf(ar[k] + cr); dst[(size_t)k * AGK + 64] = (bf16)f2bf(ai[k] + ci); const float nr = Lr * cr - Li * ci, ni = Lr * ci + Li * cr; cr = nr; ci = ni; }
    __syncthreads();
}
template <int KG> __device__ __forceinline__ void pool_half_t(int tb, int oct, const bf16* V, bf16* PO) {
    constexpr int W = 2 << KG, NR = 7 + W;
    const bf16* vp = V + oct * 8; bf16* op = PO + oct * 8;
    v4u q[NR];
#pragma unroll
    for (int j = 0; j < NR; ++j) { const int sr = tb - (W - 1) + j; q[j] = (v4u){0u, 0u, 0u, 0u}; if (sr >= 0) q[j] = *(const v4u*)(vp + (size_t)sr * 1024); }
    float sum[8];
#pragma unroll
    for (int j = 0; j < 8; ++j) sum[j] = 0.f;
#pragma unroll
    for (int j = 0; j < W - 1; ++j) { const v4u r = q[j];
        sum[0] += pg8::bf_lo(r.x); sum[1] += pg8::bf_hi(r.x); sum[2] += pg8::bf_lo(r.y); sum[3] += pg8::bf_hi(r.y); sum[4] += pg8::bf_lo(r.z); sum[5] += pg8::bf_hi(r.z); sum[6] += pg8::bf_lo(r.w); sum[7] += pg8::bf_hi(r.w); }
#pragma unroll
    for (int i = 0; i < 8; ++i) { const int t = tb + i; const v4u c = q[W - 1 + i];
        const float cur[8] = {pg8::bf_lo(c.x), pg8::bf_hi(c.x), pg8::bf_lo(c.y), pg8::bf_hi(c.y), pg8::bf_lo(c.z), pg8::bf_hi(c.z), pg8::bf_lo(c.w), pg8::bf_hi(c.w)};
        const float inv = 1.0f / (float)(t + 1 < W ? t + 1 : W); float o[8];
#pragma unroll
        for (int j = 0; j < 8; ++j) { sum[j] += cur[j]; o[j] = sum[j] * inv - cur[j]; }
        v4u ow; ow.x = pk2(o[0], o[1]); ow.y = pk2(o[2], o[3]); ow.z = pk2(o[4], o[5]); ow.w = pk2(o[6], o[7]);
        *(v4u*)(op + (size_t)t * 1024) = ow;
        const v4u r = q[i];
        sum[0] -= pg8::bf_lo(r.x); sum[1] -= pg8::bf_hi(r.x); sum[2] -= pg8::bf_lo(r.y); sum[3] -= pg8::bf_hi(r.y); sum[4] -= pg8::bf_lo(r.z); sum[5] -= pg8::bf_hi(r.z); sum[6] -= pg8::bf_lo(r.w); sum[7] -= pg8::bf_hi(r.w); }
}
__device__ __forceinline__ void pool_half(int kg, int tb, int oct, const bf16* V, bf16* PO) {
    if (kg == 0) pool_half_t<0>(tb, oct, V, PO); else if (kg == 1) pool_half_t<1>(tb, oct, V, PO); else if (kg == 2) pool_half_t<2>(tb, oct, V, PO); else pool_half_t<3>(tb, oct, V, PO);
}
__device__ __forceinline__ void pool_run(int kg, int t0, int oct, const bf16* V, bf16* PO) {
#pragma unroll 1
    for (int hh = 0; hh < 2; ++hh) pool_half(kg, t0 + 8 * hh, oct, V, PO);
}
__device__ __forceinline__ void pool_tile_workers(int bx, int wave, int lane, const bf16* V, bf16* PO) {
    const int kg = bx >> 6, pm = (bx & 7) * 8 + ((bx >> 3) & 7);
#pragma unroll 1
    for (int h = (wave - 1) * 64 + lane; h < 1024; h += 448) pool_half(kg, 256 * pm + 8 * (h >> 5), kg * 32 + (h & 31), V, PO);
}

__device__ __forceinline__ void pool_item(int idx, const bf16* V, bf16* PO) { const int kg = (idx >> 6) & 3; pool_run(kg, (2 * (idx >> 8) + ((idx >> 5) & 1)) * 16, kg * 32 + (idx & 31), V, PO); }
__device__ __forceinline__ void s5_scan_merged(int u, LAS unsigned char* lds, int wave, int lane, const float* SLOC, const float* LT, bf16* AG, unsigned long long* XE, unsigned* XF, unsigned* tmo,
                                               const bf16* V, bf16* PO) {
    const int g = u >> 2, pmm = u & 3, p = lane, sg = wave, c0 = pmm * 256;
    const float Lr = LT[(g * 64 + p) * 2], Li = LT[(g * 64 + p) * 2 + 1];
    const float* base = SLOC + ((size_t)(g * NCHK + c0 + sg * 32)) * 128 + p;
    float ar[32], ai[32];
#pragma unroll
    for (int k = 0; k < 32; ++k) { ar[k] = base[(size_t)k * 128]; ai[k] = base[(size_t)k * 128 + 64]; }
    float sr = 0.f, si = 0.f;
#pragma unroll
    for (int k = 0; k < 32; ++k) { const float tr = ar[k], ti = ai[k]; ar[k] = sr; ai[k] = si; const float nr = Lr * sr - Li * si + tr, ni = Lr * si + Li * sr + ti; sr = nr; si = ni; }
    LAS float* End = (LAS float*)lds;
    End[(sg * 64 + p) * 2] = sr; End[(sg * 64 + p) * 2 + 1] = si;
    __syncthreads();
    float Mr = Lr, Mi = Li;
#pragma unroll
    for (int q = 0; q < 5; ++q) { const float nr = Mr * Mr - Mi * Mi, ni = 2.f * Mr * Mi; Mr = nr; Mi = ni; }
    float cr = 0.f, ci = 0.f;
    for (int s2 = 0; s2 < sg; ++s2) { const float er = End[(s2 * 64 + p) * 2], ei = End[(s2 * 64 + p) * 2 + 1]; const float nr = Mr * cr - Mi * ci + er, ni = Mr * ci + Mi * cr + ei; cr = nr; ci = ni; }
    if (sg == 7) {
        const float er = Mr * cr - Mi * ci + sr, ei = Mr * ci + Mi * cr + si;
        __hip_atomic_store(XE + (size_t)u * 128 + p, (1ull << 32) | __float_as_uint(er), __ATOMIC_RELAXED, __HIP_MEMORY_SCOPE_AGENT);
        __hip_atomic_store(XE + (size_t)u * 128 + 64 + p, (1ull << 32) | __float_as_uint(ei), __ATOMIC_RELAXED, __HIP_MEMORY_SCOPE_AGENT);
    }
    float M8r = Mr, M8i = Mi;
#pragma unroll
    for (int q = 0; q < 3; ++q) { const float nr = M8r * M8r - M8i * M8i, ni = 2.f * M8r * M8i; M8r = nr; M8i = ni; }
    float Cr = 0.f, Ci = 0.f;
    if (pmm > 0) {
        unsigned long long er_[3], ei_[3]; unsigned sp = 0;
        for (;;) { bool ok = true;
#pragma unroll
            for (int j = 0; j < 3; ++j) { er_[j] = 1ull << 32; ei_[j] = 1ull << 32;
                if (j < pmm) { const unsigned long long* q = XE + (size_t)(g * 4 + j) * 128 + p; er_[j] = __hip_atomic_load(q, __ATOMIC_RELAXED, __HIP_MEMORY_SCOPE_AGENT); ei_[j] = __hip_atomic_load(q + 64, __ATOMIC_RELAXED, __HIP_MEMORY_SCOPE_AGENT); }
                ok = ok && ((unsigned)(er_[j] >> 32) == 1u) && ((unsigned)(ei_[j] >> 32) == 1u); }
            if (__all(ok ? 1 : 0)) break;
            __builtin_amdgcn_s_sleep(2); if (++sp > (1u << 20)) { if (lane == 0) __hip_atomic_store(tmo, 1u, __ATOMIC_RELAXED, __HIP_MEMORY_SCOPE_AGENT); break; } }
#pragma unroll
        for (int j = 0; j < 3; ++j) if (j < pmm) { const float er = __uint_as_float((unsigned)er_[j]), ei = __uint_as_float((unsigned)ei_[j]);
            const float nr = M8r * Cr - M8i * Ci + er, ni = M8r * Ci + M8i * Cr + ei; Cr = nr; Ci = ni; }
    }
    for (int q = 0; q < sg; ++q) { const float nr = Mr * Cr - Mi * Ci, ni = Mr * Ci + Mi * Cr; Cr = nr; Ci = ni; }
    cr += Cr; ci += Ci;
    bf16* dst = AG + ((size_t)(g * NCHK + c0 + sg * 32)) * AGK + 256 + p;
#pragma unroll
    for (int k = 0; k < 32; ++k) { dst[(size_t)k * AGK] = (bf16)f2bf(ar[k] + cr); dst[(size_t)k * AGK + 64] = (bf16)f2bf(ai[k] + ci); const float nr = Lr * cr - Li * ci, ni = Lr * ci + Li * cr; cr = nr; ci = ni; }
    asm volatile("s_waitcnt vmcnt(0)" ::: "memory");
    __syncthreads();
}

struct Args { const float* in[22]; float* out; unsigned char* ws; int ph_lo, ph_hi, li, pad; };
__global__ void __launch_bounds__(NWAVES * 64, 2) mk_fwd(Args args) {
    extern __shared__ __attribute__((aligned(16))) unsigned char lds_raw[];
    LAS unsigned char* lds = (LAS unsigned char*)lds_raw;
    volatile LAS unsigned* MISC = (volatile LAS unsigned*)(lds + MISC_OFF);
    const int tid = threadIdx.x, lane = tid & 63, wave = __builtin_amdgcn_readfirstlane(tid >> 6);
    const int G = gridDim.x, bx = blockIdx.x;
    unsigned char* ws = args.ws;
    unsigned* ctl = (unsigned*)(ws + WS_CTL);
    const float* x = args.in[0]; float* out = args.out;
    bf16* WIN = (bf16*)(ws + WS_WIN); bf16* WGLU = (bf16*)(ws + WS_WGLU); bf16* WPOOL = (bf16*)(ws + WS_WPOOL); bf16* WOUT = (bf16*)(ws + WS_WOUT);
    bf16* WGU = (bf16*)(ws + WS_WGU); bf16* WDOWN = (bf16*)(ws + WS_WDOWN); bf16* BTA = (bf16*)(ws + WS_BTA); bf16* BTB = (bf16*)(ws + WS_BTB);
    bf16* XB = (bf16*)(ws + WS_XB); bf16* AG = (bf16*)(ws + WS_AG); bf16* VB = (bf16*)(ws + WS_V); float* SLOC = (float*)(ws + WS_SLOC);
    bf16* GBUF = (bf16*)(ws + WS_GBUF); bf16* POOLED = (bf16*)(ws + WS_POOLED); bf16* FFB = (bf16*)(ws + WS_FF); bf16* MIXED = (bf16*)(ws + WS_MIXED);
    float* BIASP = (float*)(ws + WS_BIASP); float* LT = (float*)(ws + WS_LT); float* RSTD1 = (float*)(ws + WS_RSTD1);
    float* ROWSS2 = (float*)(ws + WS_CTL + CTL_ROWSS2); float* ROWSS3 = (float*)(ws + WS_CTL + CTL_ROWSS3);

    for (int u = tid; u < (LDS_BYTES - LDSCTL_OFF) / 4; u += NWAVES * 64) ((LAS unsigned*)(lds + LDSCTL_OFF))[u] = 0u;
    __syncthreads();
    XcdBarrier bar; bar.bar = ctl + CW_BAR; bar.x = 0; bar.st = nullptr;
    if (!MK_PER_PHASE) bar = xcd_barrier_post(ctl + CW_BAR, MISC + 8);
    constexpr int NITEMS = 32 * 64 + 16 * 32 + 4 * 32 + 32 * 64 + 2 * 32 * 176 + 88 * 64, IT_WIN = 2048, IT_POOLGLU = 2688, IT_WOUT = 4736, IT_WGU = 16000;
    const bool defer = !MK_PER_PHASE && G == 256;
    const int NWORK = G * (NWAVES - 1);
    int dnext = IT_WIN + bx * (NWAVES - 1) + (wave - 1);
    unsigned bar_seq = 0;
#define DEFER_LIMIT(seam) ((seam) < 1 ? IT_WIN : (seam) < 5 ? IT_POOLGLU : (seam) == 5 ? IT_WOUT : (seam) == 6 ? IT_WGU : NITEMS)
#define GRID_BAR(seam) do { if (MK_PER_PHASE) { if (tid == 0) __hip_atomic_store(ctl + CW_TMO, 0xBADBA0u | (unsigned)(seam), __ATOMIC_RELAXED, __HIP_MEMORY_SCOPE_AGENT); } else { \
        LAS float* scr_ = (LAS float*)(lds + RING_OFF + wave * 16384); \
        if (defer && wave != 0) { const int lim_ = DEFER_LIMIT(seam); while (dnext < lim_) { titem_run(dnext, args.in, WIN, WGLU, WPOOL, WOUT, WGU, WDOWN, scr_, lane); dnext += NWORK; } } \
        asm volatile("s_waitcnt vmcnt(0)" ::: "memory"); __syncthreads(); ++bar_seq; \
        if (wave == 0) { if (threadIdx.x == 0) { xcd_barrier_protocol(bar); MISC[12] = bar_seq; } } \
        else if (defer) { if ((seam) == 4) pool_tile_workers(bx, wave, lane, VB, POOLED);     \
            while (MISC[12] != bar_seq) { if (dnext < NITEMS) { titem_run(dnext, args.in, WIN, WGLU, WPOOL, WOUT, WGU, WDOWN, scr_, lane); dnext += NWORK; } else __builtin_amdgcn_s_sleep(8); } } \
        asm volatile("s_waitcnt vmcnt(0)" ::: "memory"); __syncthreads(); } } while (0)
    const int cu = defer ? ((bx & 7) * 32 + (bx >> 3)) : bx;
    const int lo = args.ph_lo, hi = args.ph_hi;
#define IN(k) (lo <= (k) && (k) < hi)
#define BOTH(k) (IN(k) && IN((k) + 1))
#define REPS(k) (((MK_PROBE_MASK >> (k)) & 1) ? 2 : 1)
    float* const DUMMY_OUT = (float*)(ws + 342 * MiB); float* const DUMMY_SS = (float*)(ws + 470 * MiB); bf16* const DUMMY_HB = (bf16*)(ws + 406 * MiB);

    if (IN(0)) for (int rep = REPS(0); rep > 0; --rep) {
        LAS float* scr = (LAS float*)(lds + RING_OFF + wave * 16384);
        const int gw = bx * NWAVES + wave, NGW = G * NWAVES;
        if (defer) {
            if ((bx & 3) == 3) s5_tables_group(bx >> 2, lds, tid, args.in[3], args.in[4], args.in[5], args.in[6], args.in[7], args.in[8], args.in[9], args.in[10], BTA, BTB, LT);
            else { const int nw = (bx - (bx >> 2)) * NWAVES + wave, NNW = (G - NGRP) * NWAVES;
                for (int m = nw; m < SEQ / 2; m += NNW) x_rows2_to_bf16(x, XB, RSTD1, 2 * m, 2 * m + 1, lane);
                for (int it = nw; it < IT_WIN; it += NNW) titem_run(it, args.in, WIN, WGLU, WPOOL, WOUT, WGU, WDOWN, scr, lane); }
        } else {
            for (int g = bx; g < NGRP; g += G) s5_tables_group(g, lds, tid, args.in[3], args.in[4], args.in[5], args.in[6], args.in[7], args.in[8], args.in[9], args.in[10], BTA, BTB, LT);
            for (int m = gw; m < SEQ / 2; m += NGW) x_rows2_to_bf16(x, XB, RSTD1, 2 * m, 2 * m + 1, lane);
            for (int it = gw; it < NITEMS; it += NGW) titem_run(it, args.in, WIN, WGLU, WPOOL, WOUT, WGU, WDOWN, scr, lane);
        }
        if (bx == 0) for (int i = tid; i < 1024; i += NWAVES * 64) BIASP[i] = args.in[14][i] * args.in[15][i];
        for (int i = bx * (NWAVES * 64) + tid; i < 256 * 128; i += G * NWAVES * 64) ((unsigned long long*)(ws + WS_XE))[i] = 0ull;
        if (BOTH(0) || rep > 1) GRID_BAR(0);
    }
    if (IN(1)) for (int rep = REPS(1); rep > 0; --rep) {
        pg8::Gemm g{XB, WIN, DM, DM, DM, 128}; pg8::StaticOrder S; S.init(SEQ, DM, G, bx, DM, DM, WGM_P1);
        pg8::EpiProj E{AG, VB, RSTD1};
        pg8::gemm_phase<pg8::EpiProj, pg8::StaticOrder, PG8_ALIGN, PG8_SP2>(lds + RING_OFF, g, S, E);
        if (BOTH(1) || rep > 1) GRID_BAR(1);
    }
    if (IN(2)) for (int rep = REPS(2); rep > 0; --rep) {
        pg8::Gemm g{AG, BTA, AGK, 256, 256, 0}; pg8::GroupOrder S{NGRP * 4, G, cu, AGK, 4, (long long)128 * 256};
        pg8::EpiSloc E{SLOC};
        pg8::gemm_phase<pg8::EpiSloc, pg8::GroupOrder, PG8_ALIGN, PG8_SP2>(lds + RING_OFF, g, S, E);
        if (!defer && (BOTH(2) || rep > 1)) GRID_BAR(2);
    }
    if (IN(3)) for (int rep = REPS(3); rep > 0; --rep) {
        if (defer) s5_scan_merged(cu, lds, wave, lane, SLOC, LT, AG, (unsigned long long*)(ws + WS_XE), ctl + CW_XF, ctl + CW_TMO, VB, POOLED);
        else { for (int w = bx; w < 256; w += G) s5_scan_item(w, lds, tid, SLOC, LT, AG);
               for (int idx = bx * (NWAVES * 64) + tid; idx < 131072; idx += G * NWAVES * 64) pool_item(idx, VB, POOLED); }
        if (!defer && (BOTH(3) || rep > 1)) GRID_BAR(3);
    }
    if (IN(4)) for (int rep = REPS(4); rep > 0; --rep) {
        { pg8::Gemm g{AG, BTB, AGK, AGK, AGK, 128}; pg8::GroupOrder S{NGRP * 4, G, cu, AGK, 4, (long long)256 * AGK};
          pg8::EpiS5Out E{GBUF};
          pg8::gemm_phase<pg8::EpiS5Out, pg8::GroupOrder, PG8_ALIGN, PG8_SP2>(lds + RING_OFF, g, S, E); }
        if (!defer) { pg8::Gemm g{POOLED, WPOOL, 1024, 1024, 256, 128}; pg8::PoolOrder S{256, G, bx};
          pg8::EpiPoolOut E{MIXED, BIASP};
          pg8::gemm_phase<pg8::EpiPoolOut, pg8::PoolOrder, PG8_ALIGN, PG8_SP2>(lds + RING_OFF, g, S, E); }
        if (BOTH(4) || rep > 1) GRID_BAR(4);
    }
    if (IN(5)) for (int rep = REPS(5); rep > 0; --rep) {
        pg8::Gemm g{GBUF, WGLU, SSMW, SSMW, SSMW, 128}; pg8::StaticOrder S; S.init(SEQ, SSMW, G, bx, SSMW, SSMW, WGM_P5);
        pg8::EpiGlu E{MIXED, GBUF, args.in[12]};
        if (defer) { pg8::GluPoolOrder S2{S, bx, (long long)(POOLED - GBUF), (long long)(WPOOL - WGLU)}; pg8::EpiGluPool E2{E, pg8::EpiPoolOut{MIXED, BIASP}};
            pg8::gemm_phase<pg8::EpiGluPool, pg8::GluPoolOrder, PG8_ALIGN, PG8_SP2>(lds + RING_OFF, g, S2, E2); }
        else pg8::gemm_phase<pg8::EpiGlu, pg8::StaticOrder, PG8_ALIGN, PG8_SP2>(lds + RING_OFF, g, S, E);
        if (BOTH(5) || rep > 1) GRID_BAR(5);
    }
    if (IN(6)) for (int rep = REPS(6); rep > 0; --rep) {
        pg8::Gemm g{MIXED, WOUT, DM, DM, DM, 128}; pg8::StaticOrder S; S.init(SEQ, DM, G, bx, DM, DM, WGM_P6);
        pg8::EpiResidA E{XB, rep > 1 ? DUMMY_SS : ROWSS2};
        pg8::gemm_phase<pg8::EpiResidA, pg8::StaticOrder, PG8_ALIGN, PG8_SP2>(lds + RING_OFF, g, S, E);
        if (BOTH(6) || rep > 1) GRID_BAR(6);
    }
    if (IN(7)) for (int rep = REPS(7); rep > 0; --rep) {
        pg8::Gemm g{XB, WGU, DM, DM, DM, 128}; pg8::StaticOrder S; S.init(SEQ, 2 * DFF, G, bx, DM, DM, WGM_P7);
        pg8::EpiSwiglu E{FFB, ROWSS2};
        pg8::gemm_phase<pg8::EpiSwiglu, pg8::StaticOrder, PG8_ALIGN, PG8_SP2>(lds + RING_OFF, g, S, E);
        if (BOTH(7) || rep > 1) GRID_BAR(7);
    }
    if (IN(8)) {
        const bool bad = !MK_PER_PHASE && ((__hip_atomic_load(ctl + CW_BAR + XB_TMO, __ATOMIC_RELAXED, __HIP_MEMORY_SCOPE_AGENT) | __hip_atomic_load(ctl + CW_TMO, __ATOMIC_RELAXED, __HIP_MEMORY_SCOPE_AGENT)) != 0u);
        static_assert(PG8_ALIGN, "EpiFinal waits for all 64 waves of its row panel inside the epilogue: both half-workgroups must run their epilogues together (ALIGN_EPI), else the trailing half can never arrive");
        pg8::Gemm g{FFB, WDOWN, DFF, DFF, DFF, 128}; pg8::PanelOrder S{bx, DFF, DFF};
        pg8::EpiFinal E{XB, out, ROWSS3, ctl + CW_PANEL, ctl + CW_TMO, args.in[21]};
        if (G == 256 && !bad) pg8::gemm_phase<pg8::EpiFinal, pg8::PanelOrder, PG8_ALIGN, PG8_SP2>(lds + RING_OFF, g, S, E);
        else { const float qn = __builtin_nanf(""); for (size_t i = (size_t)bx * (NWAVES * 64) + tid; i < (size_t)SEQ * DM / 4; i += (size_t)G * NWAVES * 64) ((f32x4*)out)[i] = (f32x4){qn, qn, qn, qn}; }
    }
#undef IN
#undef BOTH
}

extern "C" void kernel_launch(void* const* d_in, const int* in_sizes, int n_in, void* d_out, int out_size, void* d_ws, size_t ws_size, hipStream_t stream) {
    static int grid = 0;
    if (grid == 0) {
        if (n_in != 22 || in_sizes[0] != SEQ * DM || out_size != SEQ * DM || ws_size < (MK_PROBE_MASK ? 471 * MiB : WS_END)) { fprintf(stderr, "kernel_launch: unexpected problem (n_in %d, in0 %d, out %d, ws %zu); nothing launched\n", n_in, n_in > 0 ? in_sizes[0] : -1, out_size, ws_size); grid = -1; return; }
        int dev = 0, cus = 0, per_cu = 0;
        if (hipGetDevice(&dev) != hipSuccess || hipDeviceGetAttribute(&cus, hipDeviceAttributeMultiprocessorCount, dev) != hipSuccess) { grid = -1; return; }
        if (hipFuncSetAttribute((const void*)mk_fwd, hipFuncAttributeMaxDynamicSharedMemorySize, LDS_BYTES) != hipSuccess) { fprintf(stderr, "kernel_launch: hipFuncSetAttribute failed\n"); grid = -1; return; }
        if (hipOccupancyMaxActiveBlocksPerMultiprocessor(&per_cu, (const void*)mk_fwd, NWAVES * 64, LDS_BYTES) != hipSuccess || per_cu < 1) { fprintf(stderr, "kernel_launch: occupancy query says %d blocks per CU\n", per_cu); }
        (void)hipGetLastError();
        grid = cus < 256 ? cus : 256;
    }
    if (grid < 0) return;
    (void)hipMemsetAsync((char*)d_ws + WS_CTL, 0, CTL_ZERO_BYTES, stream);
    Args a{};
    for (int i = 0; i < 22; ++i) a.in[i] = (const float*)d_in[i];
    a.out = (float*)d_out; a.ws = (unsigned char*)d_ws;
#if MK_PER_PHASE
    for (int p = 0; p < N_PHASES; ++p) { a.ph_lo = p; a.ph_hi = p + 1; a.li = p; hipLaunchKernelGGL(mk_fwd, dim3(grid), dim3(NWAVES * 64), LDS_BYTES, stream, a); }
#else
    a.ph_lo = 0; a.ph_hi = N_PHASES; a.li = 0;
    hipLaunchKernelGGL(mk_fwd, dim3(grid), dim3(NWAVES * 64), LDS_BYTES, stream, a);
#endif
}
```
